# Optimizing an MI355X kernel written in HIP

```python
import math
import jax, jax.numpy as jnp
from jax import lax
import numpy as np

D_MODEL = 1024
BATCH = 16
SEQ = 2048
DEPTH = 4

BRANCH_WIDTH = D_MODEL // 2
N_BRANCH = 3
POOL_WINDOWS = (2, 4, 8, 16)
POOL_GROUPS = len(POOL_WINDOWS)
POOL_WIDTH = BRANCH_WIDTH
POOL_GROUP_DIM = POOL_WIDTH // POOL_GROUPS
DA_HEAD_DIM = 64
DA_WIDTH = BRANCH_WIDTH
DA_HEADS = DA_WIDTH // (2 * DA_HEAD_DIM)
Q_BLOCK = 128
REL_BUCKETS = 32
REL_MAX_DIST = 128
RW_WIDTH = BRANCH_WIDTH
RW_HEAD_DIM = 64
RW_HEADS = RW_WIDTH // RW_HEAD_DIM
DECAY_RANK = 64
ICLR_RANK = 64
GATE_RANK = 128
RW_LOW = 2 * DECAY_RANK + 2 * ICLR_RANK + GATE_RANK
RW_SHIFT_WIDTH = 3 * RW_WIDTH + RW_LOW
RW_SPLITS = [RW_WIDTH, 2 * RW_WIDTH, 3 * RW_WIDTH,
             3 * RW_WIDTH + 2 * DECAY_RANK, 3 * RW_WIDTH + 2 * DECAY_RANK + 2 * ICLR_RANK]
GN_EPS = 64e-5
IN_SPLITS = [POOL_WIDTH, POOL_WIDTH + DA_WIDTH, POOL_WIDTH + 2 * DA_WIDTH,
             POOL_WIDTH + 3 * DA_WIDTH, POOL_WIDTH + 3 * DA_WIDTH + RW_SHIFT_WIDTH]
D_IN = POOL_WIDTH + 3 * DA_WIDTH + RW_SHIFT_WIDTH + N_BRANCH * D_MODEL
D_FF = 4 * D_MODEL
LN_EPS = 1e-5

kernel_name = 'hybrid_pool_diffattn_rwkv7_encoder'


def layer_norm(x, g, b):
    xf = x.astype(jnp.float32)
    mu = jnp.mean(xf, axis=-1, keepdims=True)
    var = jnp.mean(jnp.square(xf - mu), axis=-1, keepdims=True)
    return ((xf - mu) * lax.rsqrt(var + LN_EPS) * g + b).astype(x.dtype)


def multiscale_pool(u, pool_w, pool_scale):
    b, s, _ = u.shape
    uf = u.astype(jnp.float32)
    csum = jnp.concatenate([jnp.zeros((b, 1, POOL_WIDTH), jnp.float32), jnp.cumsum(uf, axis=1)], axis=1)
    t = jnp.arange(s)
    means = []
    for gi, win in enumerate(POOL_WINDOWS):
        left = win // 2
        right = win - 1 - left
        hi = jnp.minimum(t + right + 1, s)
        lo = jnp.maximum(t - left, 0)
        cg = csum[..., gi * POOL_GROUP_DIM:(gi + 1) * POOL_GROUP_DIM]
        cnt = (hi - lo).astype(jnp.float32)[None, :, None]
        means.append((cg[:, hi] - cg[:, lo]) / cnt)
    pooled = jnp.stack(means, axis=2)
    mixed = (pooled - uf.reshape(b, s, POOL_GROUPS, POOL_GROUP_DIM)).astype(u.dtype)
    y = jnp.einsum('bsgc,gcd->bsgd', mixed, pool_w).reshape(b, s, POOL_WIDTH)
    return y * pool_scale


def rel_bucket(rel):
    half = REL_BUCKETS // 2
    max_exact = half // 2
    n = jnp.abs(rel)
    nf = jnp.maximum(n, 1).astype(jnp.float32)
    large = max_exact + (jnp.log(nf / max_exact) / math.log(REL_MAX_DIST / max_exact)
                         * (half - max_exact)).astype(jnp.int32)
    large = jnp.minimum(large, half - 1)
    return jnp.where(rel > 0, half, 0) + jnp.where(n < max_exact, n, large)


def diff_attention(q, k, v, lam_vecs, subln_g, rel_table, layer_idx):
    b, s, _ = q.shape
    dtype = q.dtype
    q = q.reshape(b, s, DA_HEADS, 2, DA_HEAD_DIM) * (DA_HEAD_DIM ** -0.5)
    k = k.reshape(b, s, DA_HEADS, 2, DA_HEAD_DIM)
    v = v.reshape(b, s, DA_HEADS, 2 * DA_HEAD_DIM)
    lam_init = 0.8 - 0.6 * math.exp(-0.3 * layer_idx)
    lf = lam_vecs.astype(jnp.float32)
    lam = jnp.exp(jnp.sum(lf[0] * lf[1])) - jnp.exp(jnp.sum(lf[2] * lf[3])) + lam_init
    n_blk = s // Q_BLOCK
    qb = q.reshape(b, n_blk, Q_BLOCK, DA_HEADS, 2, DA_HEAD_DIM).transpose(1, 0, 2, 3, 4, 5)
    k_pos = jnp.arange(s)

    def block(args):
        q_blk, start = args
        logits = jnp.einsum('bqhmd,bkhmd->bhmqk', q_blk, k).astype(jnp.float32)
        rel = k_pos[None, :] - (start + jnp.arange(Q_BLOCK))[:, None]
        bias = rel_table[rel_bucket(rel)].astype(jnp.float32)
        logits = logits + bias.transpose(2, 0, 1)[None, :, None]
        p = jax.nn.softmax(logits, axis=-1)
        attn = p[:, :, 0] - lam * p[:, :, 1]
        return jnp.einsum('bhqk,bkhd->bqhd', attn.astype(v.dtype), v)

    starts = jnp.arange(n_blk) * Q_BLOCK
    o = lax.map(block, (qb, starts))
    o = o.transpose(1, 0, 2, 3, 4).reshape(b, s, DA_HEADS, 2 * DA_HEAD_DIM).astype(jnp.float32)
    o = o * lax.rsqrt(jnp.mean(o * o, axis=-1, keepdims=True) + 1e-5) * subln_g
    o = o * (1.0 - lam_init)
    return o.reshape(b, s, DA_WIDTH).astype(dtype)


def centred_token_shift(z, mu_prev, mu_next):
    prev = jnp.pad(z, ((0, 0), (1, 0), (0, 0)))[:, :-1]
    nxt = jnp.pad(z, ((0, 0), (0, 1), (0, 0)))[:, 1:]
    return z + mu_prev * (prev - z) + mu_next * (nxt - z)


def wkv7_scan(r, w, k, v, kk, a, reverse):
    b, s, h, n = r.shape

    def step(state, inp):
        r_t, w_t, k_t, v_t, kk_t, a_t = inp
        sa = jnp.einsum('bhij,bhj->bhi', state, -kk_t)
        state = (state * w_t[:, :, None, :] + sa[..., None] * (kk_t * a_t)[:, :, None, :]
                 + v_t[..., None] * k_t[:, :, None, :])
        return state, jnp.einsum('bhij,bhj->bhi', state, r_t)

    xs = tuple(jnp.moveaxis(t, 1, 0) for t in (r, w, k, v, kk, a))
    _, y = lax.scan(step, jnp.zeros((b, h, n, n), jnp.float32), xs, reverse=reverse)
    return jnp.moveaxis(y, 0, 1)


def rwkv7_bidir(z, mu_prev, mu_next, w0, w2, a0, a2, g2, k_k, k_a, r_k, gn_g, gn_b):
    out_dtype = z.dtype
    b, s, _ = z.shape
    z = centred_token_shift(z.astype(jnp.float32), mu_prev, mu_next)
    r, k, v, lw, la, lg = jnp.split(z, RW_SPLITS, axis=-1)

    def heads(t):
        return t.reshape(t.shape[:-1] + (RW_HEADS, RW_HEAD_DIM))

    lw = lw.reshape(b, s, 2, DECAY_RANK)
    la = la.reshape(b, s, 2, ICLR_RANK)
    w_log = -jax.nn.softplus(-(w0 + jnp.einsum('bsdr,drc->bsdc', jnp.tanh(lw), w2))) - 0.5
    decay = heads(jnp.exp(-jnp.exp(w_log)))
    iclr = heads(jax.nn.sigmoid(a0 + jnp.einsum('bsdr,drc->bsdc', la, a2)))
    gate = jnp.matmul(jax.nn.sigmoid(lg), g2)
    rh, kh, vh = heads(r), heads(k), heads(v)
    kk = kh * heads(k_k)
    kk = kk / jnp.maximum(jnp.sqrt(jnp.sum(kk * kk, axis=-1, keepdims=True)), 1e-12)
    k_a_h = heads(k_a)

    def direction(d, reverse):
        a_d = iclr[:, :, d]
        k_d = kh * (1.0 + (a_d - 1.0) * k_a_h)
        return wkv7_scan(rh, decay[:, :, d], k_d, vh, kk, a_d, reverse)

    y = direction(0, False) + direction(1, True)
    mu = jnp.mean(y, axis=-1, keepdims=True)
    var = jnp.mean(jnp.square(y - mu), axis=-1, keepdims=True)
    y = ((y - mu) * lax.rsqrt(var + GN_EPS)).reshape(b, s, RW_WIDTH) * gn_g + gn_b
    bonus = jnp.sum(rh * kh * heads(r_k), axis=-1, keepdims=True) * vh
    out = (y + bonus.reshape(b, s, RW_WIDTH)) * gate
    return out.astype(out_dtype)


def hybrid_mixer(h, w_in, pool_w, pool_scale, da_lambda, da_subln_g, rel_bias,
                 rw_mu_prev, rw_mu_next, rw_w0, rw_w2, rw_a0, rw_a2, rw_g2, rw_k_k, rw_k_a, rw_r_k,
                 rw_gn_g, rw_gn_b, w_branch, b_gate, w_out, layer_idx):
    b, s, _ = h.shape
    p = jnp.einsum('bsd,de->bse', h, w_in)
    u, q, k, v, zr, gl = jnp.split(p, IN_SPLITS, axis=-1)
    y_a = multiscale_pool(u, pool_w, pool_scale)
    y_b = diff_attention(q, k, v, da_lambda, da_subln_g, rel_bias, layer_idx)
    y_c = rwkv7_bidir(zr, rw_mu_prev, rw_mu_next, rw_w0, rw_w2, rw_a0, rw_a2, rw_g2,
                      rw_k_k, rw_k_a, rw_r_k, rw_gn_g, rw_gn_b)
    ys = jnp.stack([y_a, y_b, y_c], axis=2)
    branch = jnp.einsum('bsnc,ncd->bsnd', ys, w_branch)
    gates = jax.nn.sigmoid(gl.reshape(b, s, N_BRANCH, D_MODEL) + b_gate)
    merged = jnp.sum(gates * branch, axis=2)
    return jnp.einsum('bsd,de->bse', merged, w_out)


def setup_inputs(seed: int = 0) -> dict:
    key = jax.random.key(seed)
    ks = iter(jax.random.split(key, 40))
    L = DEPTH
    W = BRANCH_WIDTH
    beta = (8.0 * DEPTH) ** -0.25

    def nrm(shape, scale):
        return scale * jax.random.normal(next(ks), shape, jnp.float32)

    def unif(shape, lo, hi):
        return jax.random.uniform(next(ks), shape, jnp.float32, lo, hi)

    return {
        'x': nrm((BATCH, SEQ, D_MODEL), 1.0),
        'ln0_g': 1.0 + nrm((D_MODEL,), 0.05),
        'ln0_b': nrm((D_MODEL,), 0.01),
        'w_in': nrm((L, D_MODEL, D_IN), D_MODEL ** -0.5),
        'pool_w': nrm((L, POOL_GROUPS, POOL_GROUP_DIM, POOL_GROUP_DIM), POOL_GROUP_DIM ** -0.5),
        'pool_scale': 1.0 + nrm((L, POOL_WIDTH), 0.05),
        'da_lambda': nrm((L, 4, DA_HEAD_DIM), 0.1),
        'da_subln_g': 1.0 + nrm((L, 2 * DA_HEAD_DIM), 0.05),
        'rel_bias': nrm((REL_BUCKETS, DA_HEADS), 0.5),
        'rw_mu_prev': unif((L, RW_SHIFT_WIDTH), 0.0, 0.5),
        'rw_mu_next': unif((L, RW_SHIFT_WIDTH), 0.0, 0.5),
        'rw_w0': unif((L, 2, RW_WIDTH), -5.0, 2.0),
        'rw_w2': nrm((L, 2, DECAY_RANK, RW_WIDTH), 0.5 * DECAY_RANK ** -0.5),
        'rw_a0': nrm((L, 2, RW_WIDTH), 0.1),
        'rw_a2': nrm((L, 2, ICLR_RANK, RW_WIDTH), ICLR_RANK ** -0.5),
        'rw_g2': nrm((L, GATE_RANK, RW_WIDTH), GATE_RANK ** -0.5),
        'rw_k_k': 0.85 + nrm((L, RW_WIDTH), 0.05),
        'rw_k_a': 1.0 + nrm((L, RW_WIDTH), 0.05),
        'rw_r_k': nrm((L, RW_WIDTH), 0.1),
        'rw_gn_g': 1.0 + nrm((L, RW_WIDTH), 0.05),
        'rw_gn_b': nrm((L, RW_WIDTH), 0.01),
        'w_branch': nrm((L, N_BRANCH, W, D_MODEL), beta * W ** -0.5),
        'b_gate': nrm((L, N_BRANCH, D_MODEL), 0.01),
        'w_out': nrm((L, D_MODEL, D_MODEL), beta * D_MODEL ** -0.5),
        'ln1_g': 1.0 + nrm((L, D_MODEL), 0.05),
        'ln1_b': nrm((L, D_MODEL), 0.01),
        'w_up': nrm((L, D_MODEL, D_FF), D_MODEL ** -0.5),
        'w_down': nrm((L, D_FF, D_MODEL), beta * D_FF ** -0.5),
        'ln2_g': 1.0 + nrm((L, D_MODEL), 0.05),
        'ln2_b': nrm((L, D_MODEL), 0.01),
    }


def reference(x, ln0_g, ln0_b, w_in, pool_w, pool_scale, da_lambda, da_subln_g, rel_bias,
              rw_mu_prev, rw_mu_next, rw_w0, rw_w2, rw_a0, rw_a2, rw_g2, rw_k_k, rw_k_a, rw_r_k,
              rw_gn_g, rw_gn_b, w_branch, b_gate, w_out, ln1_g, ln1_b, w_up, w_down, ln2_g, ln2_b):
    alpha = (2.0 * DEPTH) ** 0.25
    x = layer_norm(x, ln0_g, ln0_b)
    for l in range(DEPTH):
        mix = hybrid_mixer(x, w_in[l], pool_w[l], pool_scale[l], da_lambda[l], da_subln_g[l], rel_bias,
                           rw_mu_prev[l], rw_mu_next[l], rw_w0[l], rw_w2[l], rw_a0[l], rw_a2[l], rw_g2[l],
                           rw_k_k[l], rw_k_a[l], rw_r_k[l], rw_gn_g[l], rw_gn_b[l],
                           w_branch[l], b_gate[l], w_out[l], l)
        x = layer_norm(alpha * x + mix, ln1_g[l], ln1_b[l])
        hid = jnp.square(jax.nn.relu(jnp.einsum('bsd,df->bsf', x, w_up[l])))
        x = layer_norm(alpha * x + jnp.einsum('bsf,fd->bsd', hid, w_down[l]), ln2_g[l], ln2_b[l])
    return x
```

```cpp
#include <hip/hip_runtime.h>
#include <hip/hip_cooperative_groups.h>
#include <cstdio>
namespace cg = cooperative_groups;

typedef unsigned short u16;
typedef __attribute__((ext_vector_type(8))) short bf16x8;
typedef __attribute__((ext_vector_type(4))) float f32x4;
typedef __bf16 bf2_t __attribute__((ext_vector_type(2)));
typedef float fl2_t __attribute__((ext_vector_type(2)));
typedef _Float16 h2_t __attribute__((ext_vector_type(2)));

#ifndef MULTI_LAUNCH
#define MULTI_LAUNCH 0
#endif

constexpr int SEQ = 2048, DM = 1024, NT = 16 * 2048, DEPTH = 4;
constexpr int LDP = 3968;
constexpr int PC_U = 0, PC_Q = 512, PC_K = 1024, PC_V = 1536, PC_R = 2048, PC_RK = 2560, PC_RV = 3072, PC_LW = 3584;
constexpr int NTHREADS = 512;
constexpr int LSTR = 72;
constexpr size_t MiB = 1048576;
constexpr size_t WS_WB = 0, WS_XN = 36 * MiB, WS_P = 100 * MiB, WS_PREP = 348 * MiB, WS_GATE = 476 * MiB, WS_BAR = 508 * MiB, WS_END = 508 * MiB + 4096;
constexpr size_t WO_IN = 0, WO_POOL = WO_IN + 7040 * 1024, WO_W2 = WO_POOL + 65536, WO_A2 = WO_W2 + 65536, WO_G2 = WO_A2 + 65536,
                 WO_BR = WO_G2 + 65536, WO_OUT = WO_BR + 3 * 1024 * 512, WO_UP = WO_OUT + 1024 * 1024, WO_DOWN = WO_UP + 4096 * 1024;
constexpr int LDS_BYTES = 2 * (256 + 128) * LSTR * 2;

enum { I_X = 0, I_LN0G, I_LN0B, I_WIN, I_POOLW, I_POOLS, I_LAM, I_SUBG, I_REL, I_MUP, I_MUN, I_W0, I_W2, I_A0, I_A2, I_G2, I_KK, I_KA, I_RK,
       I_GNG, I_GNB, I_WBR, I_BG, I_WOUT, I_LN1G, I_LN1B, I_WUP, I_WDOWN, I_LN2G, I_LN2B, N_IN };

struct Params {
  const float* in[N_IN];
  float* out;
  unsigned char* ws;
  int ph_lo, ph_hi;
};

typedef __attribute__((address_space(4))) const Params* KP;
__device__ __forceinline__ KP kparams() { KP k = (KP)__builtin_amdgcn_kernarg_segment_ptr(); asm volatile("" : "+s"(k)); return k; }

__device__ __forceinline__ unsigned pack2(float a, float b) { fl2_t v = {a, b}; bf2_t h = __builtin_convertvector(v, bf2_t); return __builtin_bit_cast(unsigned, h); }
__device__ __forceinline__ unsigned packh2(float a, float b) { fl2_t v = {a, b}; h2_t h = __builtin_convertvector(v, h2_t); return __builtin_bit_cast(unsigned, h); }
__device__ __forceinline__ float bflo(unsigned u) { return __uint_as_float(u << 16); }
__device__ __forceinline__ float bfhi(unsigned u) { return __uint_as_float(u & 0xffff0000u); }
__device__ __forceinline__ void unpack8(const uint4& q, float* f) {
  f[0] = bflo(q.x); f[1] = bfhi(q.x); f[2] = bflo(q.y); f[3] = bfhi(q.y); f[4] = bflo(q.z); f[5] = bfhi(q.z); f[6] = bflo(q.w); f[7] = bfhi(q.w);
}
__device__ __forceinline__ void unpackh8(const uint4& q, float* f) {
  h2_t a = __builtin_bit_cast(h2_t, q.x), b = __builtin_bit_cast(h2_t, q.y), c = __builtin_bit_cast(h2_t, q.z), d = __builtin_bit_cast(h2_t, q.w);
  f[0] = (float)a[0]; f[1] = (float)a[1]; f[2] = (float)b[0]; f[3] = (float)b[1]; f[4] = (float)c[0]; f[5] = (float)c[1]; f[6] = (float)d[0]; f[7] = (float)d[1];
}
__device__ __forceinline__ uint4 pack8(const float* f) { return make_uint4(pack2(f[0], f[1]), pack2(f[2], f[3]), pack2(f[4], f[5]), pack2(f[6], f[7])); }
__device__ __forceinline__ float sigmoidf_(float x) { return 1.0f / (1.0f + __expf(-x)); }
__device__ __forceinline__ int otid() { int t = threadIdx.x; asm volatile("" : "+v"(t)); return t; }
__device__ __forceinline__ float xor_sum(float v, int m) { return v + __shfl_xor(v, m); }

__device__ __forceinline__ void conv_tile(const float* __restrict__ src, int K, int N, u16* __restrict__ dst, int tile, float* sm) {
  const int tid = otid();
  const int tn = N >> 6;
  const int k0 = (tile / tn) * 64, n0 = (tile % tn) * 64;
#pragma unroll
  for (int i = 0; i < 2; ++i) {
    int r = (tid >> 4) + i * 32, c = (tid & 15) * 4;
    float4 v = *(const float4*)(src + (size_t)(k0 + r) * N + n0 + c);
    sm[r * 65 + c] = v.x; sm[r * 65 + c + 1] = v.y; sm[r * 65 + c + 2] = v.z; sm[r * 65 + c + 3] = v.w;
  }
  __syncthreads();
  {
    int n = tid >> 3, kc = (tid & 7) * 8;
    float f[8];
#pragma unroll
    for (int j = 0; j < 8; ++j) f[j] = sm[(kc + j) * 65 + n];
    *(uint4*)(dst + (size_t)(n0 + n) * K + k0 + kc) = pack8(f);
  }
  __syncthreads();
}

__device__ __forceinline__ void ph_convert(int l, unsigned char* smem) {
  const KP p = kparams();
  u16* wb = (u16*)(p->ws + WS_WB);
  float* sm = (float*)smem;
  for (int job = 0; job < 16; ++job) {
    const float* src; int K, N; u16* dst;
    if (job == 0) { src = p->in[I_WIN] + (size_t)l * 1024 * 7040; K = 1024; N = 7040; dst = wb + WO_IN; }
    else if (job < 5) { int g = job - 1; src = p->in[I_POOLW] + ((size_t)l * 4 + g) * 16384; K = 128; N = 128; dst = wb + WO_POOL + g * 16384; }
    else if (job < 7) { int d = job - 5; src = p->in[I_W2] + ((size_t)l * 2 + d) * 64 * 512; K = 64; N = 512; dst = wb + WO_W2 + d * 32768; }
    else if (job < 9) { int d = job - 7; src = p->in[I_A2] + ((size_t)l * 2 + d) * 64 * 512; K = 64; N = 512; dst = wb + WO_A2 + d * 32768; }
    else if (job == 9) { src = p->in[I_G2] + (size_t)l * 128 * 512; K = 128; N = 512; dst = wb + WO_G2; }
    else if (job < 13) { int n = job - 10; src = p->in[I_WBR] + ((size_t)l * 3 + n) * 512 * 1024; K = 512; N = 1024; dst = wb + WO_BR + (size_t)n * 1024 * 512; }
    else if (job == 13) { src = p->in[I_WOUT] + (size_t)l * 1024 * 1024; K = 1024; N = 1024; dst = wb + WO_OUT; }
    else if (job == 14) { src = p->in[I_WUP] + (size_t)l * 1024 * 4096; K = 1024; N = 4096; dst = wb + WO_UP; }
    else { src = p->in[I_WDOWN] + (size_t)l * 4096 * 1024; K = 4096; N = 1024; dst = wb + WO_DOWN; }
    int ntile = (K >> 6) * (N >> 6);
    for (int t = blockIdx.x; t < ntile; t += gridDim.x) conv_tile(src, K, N, dst, t, sm);
  }
}

__device__ __forceinline__ void ph_ln(const float* in, const float* __restrict__ g, const float* __restrict__ b, float* outf, u16* outb) {
  const int tid_ = otid();
  const int wave = tid_ >> 6, lane = tid_ & 63;
  for (int row = blockIdx.x * 8 + wave; row < NT; row += gridDim.x * 8) {
    const float4* src = (const float4*)(in + (size_t)row * DM);
    float4 v[4];
#pragma unroll
    for (int i = 0; i < 4; ++i) v[i] = src[lane + 64 * i];
    float s = 0.f;
#pragma unroll
    for (int i = 0; i < 4; ++i) s += v[i].x + v[i].y + v[i].z + v[i].w;
#pragma unroll
    for (int m = 1; m < 64; m <<= 1) s = xor_sum(s, m);
    float mu = s * (1.0f / DM);
    float q = 0.f;
#pragma unroll
    for (int i = 0; i < 4; ++i) { float a = v[i].x - mu, bb = v[i].y - mu, c = v[i].z - mu, d = v[i].w - mu; q += a * a + bb * bb + c * c + d * d; }
#pragma unroll
    for (int m = 1; m < 64; m <<= 1) q = xor_sum(q, m);
    float rs = rsqrtf(q * (1.0f / DM) + 1e-5f);
#pragma unroll
    for (int i = 0; i < 4; ++i) {
      int c4 = lane + 64 * i;
      float4 gg = ((const float4*)g)[c4], bb = ((const float4*)b)[c4];
      float4 o;
      o.x = (v[i].x - mu) * rs * gg.x + bb.x; o.y = (v[i].y - mu) * rs * gg.y + bb.y;
      o.z = (v[i].z - mu) * rs * gg.z + bb.z; o.w = (v[i].w - mu) * rs * gg.w + bb.w;
      ((float4*)(outf + (size_t)row * DM))[c4] = o;
      *(uint2*)(outb + (size_t)row * DM + c4 * 4) = make_uint2(pack2(o.x, o.y), pack2(o.z, o.w));
    }
  }
}

template <int TM>
__device__ __forceinline__ void gemm_kloop(f32x4 (&acc)[TM][4], const u16* __restrict__ A, int lda, const u16* __restrict__ Bt, int ldb, int K, u16* smem) {
  constexpr int BM = TM * 64;
  u16* sA = smem;
  u16* sB = smem + 2 * BM * LSTR;
  const int tid = otid(), lane = tid & 63, wave = tid >> 6, wm = wave >> 1, wn = wave & 1;
  const int lr = tid >> 3, lc = (tid & 7) * 8;
  uint4 ra0, ra1, ra2 = make_uint4(0, 0, 0, 0), ra3 = make_uint4(0, 0, 0, 0), rb0, rb1;
  const u16* ga = A + (size_t)lr * lda + lc;
  const u16* gb = Bt + (size_t)lr * ldb + lc;
#define GLOAD(k0)                                                                      \
  ra0 = *(const uint4*)(ga + (k0));                                                    \
  ra1 = *(const uint4*)(ga + (size_t)64 * lda + (k0));                                 \
  if (TM > 2) { ra2 = *(const uint4*)(ga + (size_t)128 * lda + (k0)); ra3 = *(const uint4*)(ga + (size_t)192 * lda + (k0)); } \
  rb0 = *(const uint4*)(gb + (k0));                                                    \
  rb1 = *(const uint4*)(gb + (size_t)64 * ldb + (k0));
#define SWRITE(bb)                                                                     \
  *(uint4*)(sA + ((bb) * BM + lr) * LSTR + lc) = ra0;                                  \
  *(uint4*)(sA + ((bb) * BM + lr + 64) * LSTR + lc) = ra1;                             \
  if (TM > 2) { *(uint4*)(sA + ((bb) * BM + lr + 128) * LSTR + lc) = ra2; *(uint4*)(sA + ((bb) * BM + lr + 192) * LSTR + lc) = ra3; } \
  *(uint4*)(sB + ((bb) * 128 + lr) * LSTR + lc) = rb0;                                 \
  *(uint4*)(sB + ((bb) * 128 + lr + 64) * LSTR + lc) = rb1;
  GLOAD(0)
  SWRITE(0)
  __syncthreads();
  int KT = K >> 6;
  asm volatile("" : "+s"(KT));
  for (int kt = 0; kt < KT; ++kt) {
    const int buf = kt & 1;
    if (kt + 1 < KT) {
      const int k0 = (kt + 1) * 64;
      GLOAD(k0)
    }
    const u16* a_base = sA + (buf * BM + wm * TM * 16 + (lane & 15)) * LSTR + (lane >> 4) * 8;
    const u16* b_base = sB + (buf * 128 + wn * 64 + (lane & 15)) * LSTR + (lane >> 4) * 8;
#pragma unroll
    for (int ks = 0; ks < 2; ++ks) {
      bf16x8 af[TM], bfr[4];
#pragma unroll
      for (int tm = 0; tm < TM; ++tm) af[tm] = *(const bf16x8*)(a_base + tm * 16 * LSTR + ks * 32);
#pragma unroll
      for (int tn = 0; tn < 4; ++tn) bfr[tn] = *(const bf16x8*)(b_base + tn * 16 * LSTR + ks * 32);
#pragma unroll
      for (int tm = 0; tm < TM; ++tm)
#pragma unroll
        for (int tn = 0; tn < 4; ++tn) acc[tm][tn] = __builtin_amdgcn_mfma_f32_16x16x32_bf16(bfr[tn], af[tm], acc[tm][tn], 0, 0, 0);
    }
    if (kt + 1 < KT) {
      const int nb = buf ^ 1;
      SWRITE(nb)
    }
    __syncthreads();
  }
}

template <int TM>
__device__ __forceinline__ void zero_acc(f32x4 (&acc)[TM][4]) {
#pragma unroll
  for (int tm = 0; tm < TM; ++tm)
#pragma unroll
    for (int tn = 0; tn < 4; ++tn) acc[tm][tn] = f32x4{0.f, 0.f, 0.f, 0.f};
}

__device__ __forceinline__ bool tile_sched(int it, int tiles_m, int tiles_n, int& mt, int& nt, bool& valid) {
  const int pn_cnt = (tiles_n + 7) >> 3, pm_cnt = tiles_m >> 2;
  const int npatch = pn_cnt * pm_cnt;
  const int g8 = gridDim.x >> 3;
  const int xcd = blockIdx.x & 7, j = blockIdx.x >> 3;
  const int slots_per_round = g8;
  long slot = (long)it * slots_per_round + j;
  int patch_local = (int)(slot >> 5), w = (int)(slot & 31);
  int patch = patch_local * 8 + xcd;
  if (patch >= npatch) return false;
  int pnn = patch % pn_cnt, pmm = patch / pn_cnt;
  mt = pmm * 4 + (w & 3);
  nt = pnn * 8 + (w >> 2);
  valid = (nt < tiles_n);
  return true;
}

enum { EPI_BF16 = 0, EPI_RES = 1, EPI_RELU2 = 2 };

template <int EPI>
__device__ __forceinline__ void ph_gemm(const u16* A, int lda, const u16* Bt, int ldb, int K, int N, void* Cout, int ldc, u16* smem) {
  const int tid_ = otid();
  const int lane = tid_ & 63, wave = tid_ >> 6, wm = wave >> 1, wn = wave & 1;
  const int tiles_m = NT / 256, tiles_n = N / 128;
  for (int it = 0;; ++it) {
    int mt, nt; bool valid;
    if (!tile_sched(it, tiles_m, tiles_n, mt, nt, valid)) break;
    if (!valid) continue;
    f32x4 acc[4][4];
    zero_acc<4>(acc);
    gemm_kloop<4>(acc, A + (size_t)mt * 256 * lda, lda, Bt + (size_t)nt * 128 * ldb, ldb, K, smem);
#pragma unroll
    for (int tm = 0; tm < 4; ++tm) {
      const int m = mt * 256 + wm * 64 + tm * 16 + (lane & 15);
#pragma unroll
      for (int tn = 0; tn < 4; ++tn) {
        const int n = nt * 128 + wn * 64 + tn * 16 + (lane >> 4) * 4;
        f32x4 a = acc[tm][tn];
        if (EPI == EPI_BF16) {
          *(uint2*)((u16*)Cout + (size_t)m * ldc + n) = make_uint2(pack2(a[0], a[1]), pack2(a[2], a[3]));
        } else if (EPI == EPI_RELU2) {
          float r0 = fmaxf(a[0], 0.f), r1 = fmaxf(a[1], 0.f), r2 = fmaxf(a[2], 0.f), r3 = fmaxf(a[3], 0.f);
          *(uint2*)((u16*)Cout + (size_t)m * ldc + n) = make_uint2(pack2(r0 * r0, r1 * r1), pack2(r2 * r2, r3 * r3));
        } else {
          float4* px = (float4*)((float*)Cout + (size_t)m * ldc + n);
          float4 x = *px;
          const float al = 1.681792830507429f;
          x.x = al * x.x + a[0]; x.y = al * x.y + a[1]; x.z = al * x.z + a[2]; x.w = al * x.w + a[3];
          *px = x;
        }
      }
    }
  }
}

__device__ __forceinline__ void ph_prep_gemm(int l, u16* smem) {
  const KP p = kparams();
  const int tid_ = otid();
  const int lane = tid_ & 63, wave = tid_ >> 6, wm = wave >> 1, wn = wave & 1;
  u16* P = (u16*)(p->ws + WS_P);
  const u16* wb = (const u16*)(p->ws + WS_WB);
  u16* prepE = (u16*)(p->ws + WS_PREP);
  u16* prepA = prepE + (size_t)2 * NT * 512;
  u16* gate = (u16*)(p->ws + WS_GATE);
  const int total = 512 + 5 * 512;
  for (int t = blockIdx.x; t < total; t += gridDim.x) {
    int job, mt, nt;
    if (t < 512) { job = t & 3; mt = t >> 2; nt = 0; }
    else { int t2 = t - 512; job = 4 + (t2 >> 9); int r = t2 & 511; nt = r & 3; mt = r >> 2; }
    const u16 *A, *Bt; int K, ldb;
    if (job < 4) { A = P + PC_K + job * 128; Bt = wb + WO_POOL + job * 16384; K = 128; ldb = 128; }
    else if (job < 6) { int d = job - 4; A = P + PC_V + d * 64; Bt = wb + WO_W2 + d * 32768; K = 64; ldb = 64; }
    else if (job < 8) { int d = job - 6; A = P + PC_V + 128 + d * 64; Bt = wb + WO_A2 + d * 32768; K = 64; ldb = 64; }
    else { A = P + PC_V + 256; Bt = wb + WO_G2; K = 128; ldb = 128; }
    f32x4 acc[4][4];
    zero_acc<4>(acc);
    gemm_kloop<4>(acc, A + (size_t)mt * 256 * LDP, LDP, Bt + (size_t)nt * 128 * ldb, ldb, K, smem);
#pragma unroll
    for (int tm = 0; tm < 4; ++tm) {
      const int m = mt * 256 + wm * 64 + tm * 16 + (lane & 15);
#pragma unroll
      for (int tn = 0; tn < 4; ++tn) {
        const int n = nt * 128 + wn * 64 + tn * 16 + (lane >> 4) * 4;
        f32x4 a = acc[tm][tn];
        if (job < 4) {
          float4 sc = *(const float4*)(p->in[I_POOLS] + (size_t)l * 512 + job * 128 + n);
          *(uint2*)(P + (size_t)m * LDP + PC_K + job * 128 + n) = make_uint2(pack2(a[0] * sc.x, a[1] * sc.y), pack2(a[2] * sc.z, a[3] * sc.w));
        } else if (job < 6) {
          int d = job - 4;
          float4 w0 = *(const float4*)(p->in[I_W0] + ((size_t)l * 2 + d) * 512 + n);
          const float c = 0.6065306597126334f;
          float e0 = c * sigmoidf_(w0.x + a[0]), e1 = c * sigmoidf_(w0.y + a[1]), e2 = c * sigmoidf_(w0.z + a[2]), e3 = c * sigmoidf_(w0.w + a[3]);
          *(uint2*)(prepE + ((size_t)d * NT + m) * 512 + n) = make_uint2(packh2(e0, e1), packh2(e2, e3));
        } else if (job < 8) {
          int d = job - 6;
          float4 a0 = *(const float4*)(p->in[I_A0] + ((size_t)l * 2 + d) * 512 + n);
          float e0 = sigmoidf_(a0.x + a[0]), e1 = sigmoidf_(a0.y + a[1]), e2 = sigmoidf_(a0.z + a[2]), e3 = sigmoidf_(a0.w + a[3]);
          *(uint2*)(prepA + ((size_t)d * NT + m) * 512 + n) = make_uint2(packh2(e0, e1), packh2(e2, e3));
        } else {
          *(uint2*)(gate + (size_t)m * 512 + n) = make_uint2(pack2(a[0], a[1]), pack2(a[2], a[3]));
        }
      }
    }
  }
}

__device__ __forceinline__ void ph_merge(int l, u16* smem) {
  const KP p = kparams();
  const int tid_ = otid();
  const int lane = tid_ & 63, wave = tid_ >> 6, wm = wave >> 1, wn = wave & 1;
  const u16* P = (const u16*)(p->ws + WS_P);
  const u16* xn = (const u16*)(p->ws + WS_XN);
  const u16* wb = (const u16*)(p->ws + WS_WB);
  u16* merged = (u16*)(p->ws + WS_PREP);
  const float* bg = p->in[I_BG] + (size_t)l * 3 * 1024;
  const int tiles_m = NT / 128, tiles_n = 8;
  for (int it = 0;; ++it) {
    int mt, nt; bool valid;
    if (!tile_sched(it, tiles_m, tiles_n, mt, nt, valid)) break;
    if (!valid) continue;
    f32x4 accM[2][4];
    zero_acc<2>(accM);
    int NB3 = 3;
    asm volatile("" : "+s"(NB3));
    for (int nb = 0; nb < NB3; ++nb) {
      f32x4 accG[2][4], accB[2][4];
      zero_acc<2>(accG);
      zero_acc<2>(accB);
      gemm_kloop<2>(accG, xn + (size_t)mt * 128 * 1024, 1024, wb + WO_IN + (size_t)(3968 + nb * 1024 + nt * 128) * 1024, 1024, 1024, smem);
      const int col = (nb == 0) ? PC_K : (nb == 1 ? PC_Q : PC_U);
      gemm_kloop<2>(accB, P + (size_t)mt * 128 * LDP + col, LDP, wb + WO_BR + (size_t)(nb * 1024 + nt * 128) * 512, 512, 512, smem);
#pragma unroll
      for (int tn = 0; tn < 4; ++tn) {
        const int n = nt * 128 + wn * 64 + tn * 16 + (lane >> 4) * 4;
        float4 b4 = *(const float4*)(bg + nb * 1024 + n);
#pragma unroll
        for (int tm = 0; tm < 2; ++tm) {
          accM[tm][tn][0] += sigmoidf_(accG[tm][tn][0] + b4.x) * accB[tm][tn][0];
          accM[tm][tn][1] += sigmoidf_(accG[tm][tn][1] + b4.y) * accB[tm][tn][1];
          accM[tm][tn][2] += sigmoidf_(accG[tm][tn][2] + b4.z) * accB[tm][tn][2];
          accM[tm][tn][3] += sigmoidf_(accG[tm][tn][3] + b4.w) * accB[tm][tn][3];
        }
      }
    }
#pragma unroll
    for (int tm = 0; tm < 2; ++tm) {
      const int m = mt * 128 + wm * 32 + tm * 16 + (lane & 15);
#pragma unroll
      for (int tn = 0; tn < 4; ++tn) {
        const int n = nt * 128 + wn * 64 + tn * 16 + (lane >> 4) * 4;
        f32x4 a = accM[tm][tn];
        *(uint2*)(merged + (size_t)m * 1024 + n) = make_uint2(pack2(a[0], a[1]), pack2(a[2], a[3]));
      }
    }
  }
}

__device__ __forceinline__ int rel_bucket_dev(int rel) {
  int n = rel < 0 ? -rel : rel;
  int b;
  if (n < 8) b = n; else if (n < 12) b = 8; else if (n < 16) b = 9; else if (n < 23) b = 10; else if (n < 32) b = 11;
  else if (n < 46) b = 12; else if (n < 64) b = 13; else if (n < 91) b = 14; else b = 15;
  return b + (rel > 0 ? 16 : 0);
}

__device__ __forceinline__ void ph_attn(int l, unsigned char* smem_raw) {
  const KP p = kparams();
  constexpr int KSTR = 136, VSTR = 72;
  u16* sK = (u16*)smem_raw;
  u16* sVt = sK + 2 * 64 * KSTR;
  float* lut = (float*)(sVt + 2 * 128 * VSTR);
  u16* P = (u16*)(p->ws + WS_P);
  const int tid = otid(), lane = tid & 63, wave = tid >> 6, g = lane >> 4, l15 = lane & 15;
  const float LOG2E = 1.4426950408889634f;
  const float* lf = p->in[I_LAM] + (size_t)l * 256;
  float s01 = lf[lane] * lf[64 + lane], s23 = lf[128 + lane] * lf[192 + lane];
#pragma unroll
  for (int m = 1; m < 64; m <<= 1) { s01 = xor_sum(s01, m); s23 = xor_sum(s23, m); }
  const float lam_init = 0.8f - 0.6f * __expf(-0.3f * (float)l);
  const float lam = __expf(s01) - __expf(s23) + lam_init;
  const float* relb = p->in[I_REL];
  const float* subg = p->in[I_SUBG] + (size_t)l * 128;
  const int g8 = gridDim.x >> 3, xcd = blockIdx.x & 7, jb = blockIdx.x >> 3;
  for (int it = 0;; ++it) {
    const int unit = (it * 8 + xcd) * g8 + jb;
    if (it * 8 * g8 >= 1024) break;
    if (unit >= 1024) continue;
    const int b = unit >> 6, h = (unit >> 4) & 3, qb = unit & 15;
    const size_t tok0 = (size_t)b * SEQ;
    __syncthreads();
    if (tid < 257) lut[tid] = relb[rel_bucket_dev(tid - 128) * 4 + h] * LOG2E;
    const float bias_far_neg = relb[15 * 4 + h] * LOG2E, bias_far_pos = relb[31 * 4 + h] * LOG2E;
    const int qpos = qb * 128 + wave * 16 + l15;
    bf16x8 qf[2][2];
    {
      const u16* qp = P + (tok0 + qpos) * LDP + PC_Q + h * 128 + g * 8;
#pragma unroll
      for (int mp = 0; mp < 2; ++mp)
#pragma unroll
        for (int ks = 0; ks < 2; ++ks) qf[mp][ks] = *(const bf16x8*)(qp + mp * 64 + ks * 32);
    }
    f32x4 O[2][8];
#pragma unroll
    for (int mp = 0; mp < 2; ++mp)
#pragma unroll
      for (int d = 0; d < 8; ++d) O[mp][d] = f32x4{0.f, 0.f, 0.f, 0.f};
    float mrow[2] = {-1e30f, -1e30f}, lrow[2] = {0.f, 0.f};
    const u16* kg = P + (tok0 + (tid >> 4)) * LDP + PC_K + h * 128 + (tid & 15) * 8;
    const u16* vg = P + (tok0 + lane) * LDP + PC_V + h * 128 + wave * 16;
    uint4 rk0, rk1, rv0, rv1;
    rk0 = *(const uint4*)(kg); rk1 = *(const uint4*)(kg + (size_t)32 * LDP); rv0 = *(const uint4*)(vg); rv1 = *(const uint4*)(vg + 8);
#define VST(vd, rv)                                                                   \
  vd[0 * VSTR] = (u16)(rv.x & 0xffff); vd[1 * VSTR] = (u16)(rv.x >> 16);              \
  vd[2 * VSTR] = (u16)(rv.y & 0xffff); vd[3 * VSTR] = (u16)(rv.y >> 16);              \
  vd[4 * VSTR] = (u16)(rv.z & 0xffff); vd[5 * VSTR] = (u16)(rv.z >> 16);              \
  vd[6 * VSTR] = (u16)(rv.w & 0xffff); vd[7 * VSTR] = (u16)(rv.w >> 16);
#define STAGE(bb)                                                                     \
  {                                                                                   \
    *(uint4*)(sK + ((bb) * 64 + (tid >> 4)) * KSTR + (tid & 15) * 8) = rk0;           \
    *(uint4*)(sK + ((bb) * 64 + (tid >> 4) + 32) * KSTR + (tid & 15) * 8) = rk1;      \
    u16* vd0 = sVt + ((bb) * 128 + wave * 16) * VSTR + lane;                          \
    u16* vd1 = vd0 + 8 * VSTR;                                                        \
    VST(vd0, rv0) VST(vd1, rv1)                                                       \
  }
    STAGE(0)
    __syncthreads();
    int NKT = 32;
    asm volatile("" : "+s"(NKT));
    for (int kt = 0; kt < NKT; ++kt) {
      const int buf = kt & 1;
      if (kt + 1 < NKT) {
        rk0 = *(const uint4*)(kg + ((size_t)(kt + 1) * 64) * LDP);
        rk1 = *(const uint4*)(kg + ((size_t)(kt + 1) * 64 + 32) * LDP);
        rv0 = *(const uint4*)(vg + (size_t)(kt + 1) * 64 * LDP);
        rv1 = *(const uint4*)(vg + (size_t)(kt + 1) * 64 * LDP + 8);
      }
      f32x4 sc[2][4];
#pragma unroll
      for (int mp = 0; mp < 2; ++mp)
#pragma unroll
        for (int kk = 0; kk < 4; ++kk) {
          f32x4 a = {0.f, 0.f, 0.f, 0.f};
#pragma unroll
          for (int ks = 0; ks < 2; ++ks) {
            bf16x8 kf = *(const bf16x8*)(sK + (buf * 64 + kk * 16 + l15) * KSTR + mp * 64 + ks * 32 + g * 8);
            a = __builtin_amdgcn_mfma_f32_16x16x32_bf16(kf, qf[mp][ks], a, 0, 0, 0);
          }
          sc[mp][kk] = a;
          if (kk & 1) __builtin_amdgcn_sched_barrier(0);
        }
      const int kmin = kt * 64, qmin = qb * 128 + wave * 16;
      const float qs = 0.125f * LOG2E;
      if (kmin - (qmin + 15) >= 91 || qmin - (kmin + 63) >= 91) {
        const float bb = (kmin > qmin) ? bias_far_pos : bias_far_neg;
#pragma unroll
        for (int mp = 0; mp < 2; ++mp)
#pragma unroll
          for (int kk = 0; kk < 4; ++kk)
#pragma unroll
            for (int j = 0; j < 4; ++j) sc[mp][kk][j] = sc[mp][kk][j] * qs + bb;
      } else {
#pragma unroll
        for (int kk = 0; kk < 4; ++kk)
#pragma unroll
          for (int j = 0; j < 4; ++j) {
            int rel = kmin + kk * 16 + g * 4 + j - qpos;
            rel = rel < -128 ? -128 : (rel > 128 ? 128 : rel);
            const float bb = lut[rel + 128];
            sc[0][kk][j] = sc[0][kk][j] * qs + bb;
            sc[1][kk][j] = sc[1][kk][j] * qs + bb;
          }
      }
      bf16x8 pf[2][2];
#pragma unroll
      for (int mp = 0; mp < 2; ++mp) {
        float mx = sc[mp][0][0];
#pragma unroll
        for (int kk = 0; kk < 4; ++kk)
#pragma unroll
          for (int j = 0; j < 4; ++j) mx = fmaxf(mx, sc[mp][kk][j]);
        mx = fmaxf(mx, __shfl_xor(mx, 16));
        mx = fmaxf(mx, __shfl_xor(mx, 32));
        const float mnew = fmaxf(mrow[mp], mx);
        const float alpha = exp2f(mrow[mp] - mnew);
        mrow[mp] = mnew;
        float ps = 0.f;
#pragma unroll
        for (int kk = 0; kk < 4; ++kk)
#pragma unroll
          for (int j = 0; j < 4; ++j) { float e = exp2f(sc[mp][kk][j] - mnew); sc[mp][kk][j] = e; ps += e; }
        lrow[mp] = lrow[mp] * alpha + ps;
#pragma unroll
        for (int d = 0; d < 8; ++d) { O[mp][d][0] *= alpha; O[mp][d][1] *= alpha; O[mp][d][2] *= alpha; O[mp][d][3] *= alpha; }
#pragma unroll
        for (int kb = 0; kb < 2; ++kb) {
          uint4 u = make_uint4(pack2(sc[mp][2 * kb][0], sc[mp][2 * kb][1]), pack2(sc[mp][2 * kb][2], sc[mp][2 * kb][3]),
                               pack2(sc[mp][2 * kb + 1][0], sc[mp][2 * kb + 1][1]), pack2(sc[mp][2 * kb + 1][2], sc[mp][2 * kb + 1][3]));
          pf[mp][kb] = __builtin_bit_cast(bf16x8, u);
        }
      }
#pragma unroll
      for (int kb = 0; kb < 2; ++kb)
#pragma unroll
        for (int d = 0; d < 8; ++d) {
          const u16* vp = sVt + (buf * 128 + d * 16 + l15) * VSTR + kb * 32 + g * 4;
          uint2 lo = *(const uint2*)vp, hi = *(const uint2*)(vp + 16);
          bf16x8 vf = __builtin_bit_cast(bf16x8, make_uint4(lo.x, lo.y, hi.x, hi.y));
          O[0][d] = __builtin_amdgcn_mfma_f32_16x16x32_bf16(vf, pf[0][kb], O[0][d], 0, 0, 0);
          O[1][d] = __builtin_amdgcn_mfma_f32_16x16x32_bf16(vf, pf[1][kb], O[1][d], 0, 0, 0);
          if (d & 1) __builtin_amdgcn_sched_barrier(0);
        }
      if (kt + 1 < NKT) STAGE(buf ^ 1)
      __syncthreads();
    }
    float l0 = lrow[0], l1 = lrow[1];
    l0 = xor_sum(l0, 16); l0 = xor_sum(l0, 32);
    l1 = xor_sum(l1, 16); l1 = xor_sum(l1, 32);
    const float i0 = 1.0f / l0, i1 = lam / l1;
    float ss = 0.f;
#pragma unroll
    for (int d = 0; d < 8; ++d)
#pragma unroll
      for (int j = 0; j < 4; ++j) { float o = O[0][d][j] * i0 - O[1][d][j] * i1; O[0][d][j] = o; ss += o * o; }
    ss = xor_sum(ss, 16); ss = xor_sum(ss, 32);
    const float scl = rsqrtf(ss * (1.0f / 128.0f) + 1e-5f) * (1.0f - lam_init);
    u16* op = P + (tok0 + qpos) * LDP + PC_Q + h * 128 + g * 4;
#pragma unroll
    for (int d = 0; d < 8; ++d) {
      float4 gg = *(const float4*)(subg + d * 16 + g * 4);
      *(uint2*)(op + d * 16) = make_uint2(pack2(O[0][d][0] * scl * gg.x, O[0][d][1] * scl * gg.y), pack2(O[0][d][2] * scl * gg.z, O[0][d][3] * scl * gg.w));
    }
  }
}

__device__ __forceinline__ void ph_poolmix_lr(int l) {
  const KP p = kparams();
  u16* P = (u16*)(p->ws + WS_P);
  const int tid_ = otid();
  const int wave = tid_ >> 6, lane = tid_ & 63;
  const float* mup = p->in[I_MUP] + (size_t)l * 1920 + 1536;
  const float* mun = p->in[I_MUN] + (size_t)l * 1920 + 1536;
  for (int t = blockIdx.x * 8 + wave; t < NT; t += gridDim.x * 8) {
    const int s = t & (SEQ - 1);
    {
      const int c0 = lane * 8, gi = lane >> 4;
      const int win = 2 << gi, left = win >> 1, right = win - 1 - left;
      const int lo = max(s - left, 0), hi = min(s + right + 1, SEQ);
      float acc[8] = {0, 0, 0, 0, 0, 0, 0, 0}, f[8];
      for (int j = lo; j < hi; ++j) {
        uint4 q = *(const uint4*)(P + (size_t)(t - s + j) * LDP + PC_U + c0);
        unpack8(q, f);
#pragma unroll
        for (int e = 0; e < 8; ++e) acc[e] += f[e];
      }
      uint4 q = *(const uint4*)(P + (size_t)t * LDP + PC_U + c0);
      unpack8(q, f);
      const float inv = 1.0f / (float)(hi - lo);
#pragma unroll
      for (int e = 0; e < 8; ++e) acc[e] = acc[e] * inv - f[e];
      *(uint4*)(P + (size_t)t * LDP + PC_K + c0) = pack8(acc);
    }
    if (lane < 48) {
      const int c0 = lane * 8;
      float z[8], zp[8], zn[8];
      uint4 q = *(const uint4*)(P + (size_t)t * LDP + PC_LW + c0);
      unpack8(q, z);
      if (s > 0) { uint4 a = *(const uint4*)(P + (size_t)(t - 1) * LDP + PC_LW + c0); unpack8(a, zp); }
      else {
#pragma unroll
        for (int e = 0; e < 8; ++e) zp[e] = 0.f;
      }
      if (s < SEQ - 1) { uint4 a = *(const uint4*)(P + (size_t)(t + 1) * LDP + PC_LW + c0); unpack8(a, zn); }
      else {
#pragma unroll
        for (int e = 0; e < 8; ++e) zn[e] = 0.f;
      }
      float o[8];
#pragma unroll
      for (int e = 0; e < 8; ++e) {
        float v = z[e] + mup[c0 + e] * (zp[e] - z[e]) + mun[c0 + e] * (zn[e] - z[e]);
        if (c0 < 128) v = tanhf(v);
        else if (c0 >= 256) v = sigmoidf_(v);
        o[e] = v;
      }
      *(uint4*)(P + (size_t)t * LDP + PC_V + c0) = pack8(o);
    }
  }
}

#define DPP_ROW(m) " row_newbcast:" #m " row_mask:0xf bank_mask:0xf\n"
__device__ __forceinline__ float scan_dot(const float (&S)[16], float x) {
  float r;
  asm volatile("s_nop 4\n"
               "v_mul_f32_dpp %0, %17, %1" DPP_ROW(0) "v_fmac_f32_dpp %0, %17, %2" DPP_ROW(1) "v_fmac_f32_dpp %0, %17, %3" DPP_ROW(2)
               "v_fmac_f32_dpp %0, %17, %4" DPP_ROW(3) "v_fmac_f32_dpp %0, %17, %5" DPP_ROW(4) "v_fmac_f32_dpp %0, %17, %6" DPP_ROW(5)
               "v_fmac_f32_dpp %0, %17, %7" DPP_ROW(6) "v_fmac_f32_dpp %0, %17, %8" DPP_ROW(7) "v_fmac_f32_dpp %0, %17, %9" DPP_ROW(8)
               "v_fmac_f32_dpp %0, %17, %10" DPP_ROW(9) "v_fmac_f32_dpp %0, %17, %11" DPP_ROW(10) "v_fmac_f32_dpp %0, %17, %12" DPP_ROW(11)
               "v_fmac_f32_dpp %0, %17, %13" DPP_ROW(12) "v_fmac_f32_dpp %0, %17, %14" DPP_ROW(13) "v_fmac_f32_dpp %0, %17, %15" DPP_ROW(14)
               "v_fmac_f32_dpp %0, %17, %16" DPP_ROW(15)
               : "=&v"(r)
               : "v"(S[0]), "v"(S[1]), "v"(S[2]), "v"(S[3]), "v"(S[4]), "v"(S[5]), "v"(S[6]), "v"(S[7]), "v"(S[8]), "v"(S[9]), "v"(S[10]), "v"(S[11]),
                 "v"(S[12]), "v"(S[13]), "v"(S[14]), "v"(S[15]), "v"(x));
  return r;
}
#define UPD(i, m) "v_mul_f32_dpp %" #i ", %16, %" #i DPP_ROW(m) "v_fmac_f32_dpp %" #i ", %17, %19" DPP_ROW(m) "v_fmac_f32_dpp %" #i ", %18, %20" DPP_ROW(m)
__device__ __forceinline__ void scan_update(float (&S)[16], float w, float b, float kd, float sa, float v) {
  asm volatile("s_nop 4\n" UPD(0, 0) UPD(1, 1) UPD(2, 2) UPD(3, 3) UPD(4, 4) UPD(5, 5) UPD(6, 6) UPD(7, 7) UPD(8, 8) UPD(9, 9) UPD(10, 10) UPD(11, 11)
                   UPD(12, 12) UPD(13, 13) UPD(14, 14) UPD(15, 15)
               : "+v"(S[0]), "+v"(S[1]), "+v"(S[2]), "+v"(S[3]), "+v"(S[4]), "+v"(S[5]), "+v"(S[6]), "+v"(S[7]), "+v"(S[8]), "+v"(S[9]), "+v"(S[10]),
                 "+v"(S[11]), "+v"(S[12]), "+v"(S[13]), "+v"(S[14]), "+v"(S[15])
               : "v"(w), "v"(b), "v"(kd), "v"(sa), "v"(v));
}
__device__ __forceinline__ float rows_allreduce(float x) {
  f32x4 z = {0.f, 0.f, 0.f, 0.f};
  f32x4 r = __builtin_amdgcn_mfma_f32_16x16x4f32(1.0f, x, z, 0, 0, 0);
  return r[0];
}

__device__ __forceinline__ void ph_scan(int l, unsigned char* smem_raw) {
  const KP p = kparams();
  constexpr int TC = 32;
  float* sb = (float*)smem_raw;
  u16* P = (u16*)(p->ws + WS_P);
  const u16* prepE = (const u16*)(p->ws + WS_PREP);
  const u16* prepA = prepE + (size_t)2 * NT * 512;
  const int tid = otid(), wave = tid >> 6, lane = tid & 63;
  for (int chain = blockIdx.x; chain < 256; chain += gridDim.x) {
    const int b = chain >> 4, h = (chain >> 1) & 7, d = chain & 1;
    const size_t tok0 = (size_t)b * SEQ;
    const int ycol = (d == 0 ? PC_U : PC_V) + h * 64;
    float S[16];
#pragma unroll
    for (int m = 0; m < 16; ++m) S[m] = 0.f;
    float r_prev = 0.f; int t_prev = -1;
    const int ht = tid - 256, tt = ht >> 3, cq = ht & 7;
    const int ch = h * 64 + cq * 8;
    __syncthreads();
    int NCH = SEQ / TC;
    asm volatile("" : "+s"(NCH));
    for (int ci = 0; ci <= NCH; ++ci) {
      if (wave < 4) {
        if (ci >= 1) {
          const float* bufp = sb + ((ci - 1) & 1) * 6 * TC * 64;
          const int vidx = wave * 16 + (lane & 15);
          float c_kk = bufp[0 * TC * 64 + lane], c_w = bufp[1 * TC * 64 + lane], c_b = bufp[2 * TC * 64 + lane], c_kd = bufp[3 * TC * 64 + lane],
                c_r = bufp[4 * TC * 64 + lane], c_v = bufp[5 * TC * 64 + vidx];
          int NTC = TC;
          asm volatile("" : "+s"(NTC));
          for (int s = 0; s < NTC; ++s) {
            float n_kk = 0, n_w = 0, n_b = 0, n_kd = 0, n_r = 0, n_v = 0;
            if (s + 1 < NTC) {
              const float* q = bufp + (s + 1) * 64;
              n_kk = q[0 * TC * 64 + lane]; n_w = q[1 * TC * 64 + lane]; n_b = q[2 * TC * 64 + lane]; n_kd = q[3 * TC * 64 + lane];
              n_r = q[4 * TC * 64 + lane]; n_v = q[5 * TC * 64 + vidx];
            }
            float sa = rows_allreduce(scan_dot(S, c_kk));
            if (t_prev >= 0) {
              float y = rows_allreduce(scan_dot(S, r_prev));
              if (lane < 16) P[(tok0 + t_prev) * LDP + ycol + wave * 16 + lane] = (u16)(pack2(y, 0.f) & 0xffff);
            }
            scan_update(S, c_w, c_b, c_kd, sa, c_v);
            const int step = (ci - 1) * TC + s;
            t_prev = d ? (SEQ - 1 - step) : step;
            r_prev = c_r;
            c_kk = n_kk; c_w = n_w; c_b = n_b; c_kd = n_kd; c_r = n_r; c_v = n_v;
          }
        }
      } else if (ci < NCH) {
        float* bufp = sb + (ci & 1) * 6 * TC * 64;
        const int step = ci * TC + tt;
        const int t = d ? (SEQ - 1 - step) : step;
        const u16* row = P + (tok0 + t) * LDP;
        float r[8], k[8], v[8], tmp[8], tp[8], tn[8];
        const float* mup = p->in[I_MUP] + (size_t)l * 1920;
        const float* mun = p->in[I_MUN] + (size_t)l * 1920;
#pragma unroll
        for (int which = 0; which < 3; ++which) {
          const int col = PC_R + which * 512 + ch;
          uint4 q = *(const uint4*)(row + col);
          unpack8(q, tmp);
          if (t > 0) { uint4 a = *(const uint4*)(row - LDP + col); unpack8(a, tp); }
          else {
#pragma unroll
            for (int e = 0; e < 8; ++e) tp[e] = 0.f;
          }
          if (t < SEQ - 1) { uint4 a = *(const uint4*)(row + LDP + col); unpack8(a, tn); }
          else {
#pragma unroll
            for (int e = 0; e < 8; ++e) tn[e] = 0.f;
          }
#pragma unroll
          for (int e = 0; e < 8; ++e) {
            float z = tmp[e] + mup[which * 512 + ch + e] * (tp[e] - tmp[e]) + mun[which * 512 + ch + e] * (tn[e] - tmp[e]);
            if (which == 0) r[e] = z; else if (which == 1) k[e] = z; else v[e] = z;
          }
        }
        float ee[8], aa[8];
        { uint4 q = *(const uint4*)(prepE + ((size_t)d * NT + tok0 + t) * 512 + ch); unpackh8(q, ee); }
        { uint4 q = *(const uint4*)(prepA + ((size_t)d * NT + tok0 + t) * 512 + ch); unpackh8(q, aa); }
        const float* kkp = p->in[I_KK] + (size_t)l * 512 + ch;
        const float* kap = p->in[I_KA] + (size_t)l * 512 + ch;
        float kk[8], nrm = 0.f;
#pragma unroll
        for (int e = 0; e < 8; ++e) { kk[e] = k[e] * kkp[e]; nrm += kk[e] * kk[e]; }
        nrm = xor_sum(nrm, 1); nrm = xor_sum(nrm, 2); nrm = xor_sum(nrm, 4);
        const float inv = 1.0f / fmaxf(sqrtf(nrm), 1e-12f);
        float o_kk[8], o_w[8], o_b[8], o_kd[8];
#pragma unroll
        for (int e = 0; e < 8; ++e) {
          float kn = kk[e] * inv;
          o_kk[e] = -kn;
          o_w[e] = __expf(-ee[e]);
          o_b[e] = kn * aa[e];
          o_kd[e] = k[e] * (1.0f + (aa[e] - 1.0f) * kap[e]);
        }
        float* dst = bufp + tt * 64 + cq * 8;
        *(float4*)(dst + 0 * TC * 64) = make_float4(o_kk[0], o_kk[1], o_kk[2], o_kk[3]); *(float4*)(dst + 0 * TC * 64 + 4) = make_float4(o_kk[4], o_kk[5], o_kk[6], o_kk[7]);
        *(float4*)(dst + 1 * TC * 64) = make_float4(o_w[0], o_w[1], o_w[2], o_w[3]); *(float4*)(dst + 1 * TC * 64 + 4) = make_float4(o_w[4], o_w[5], o_w[6], o_w[7]);
        *(float4*)(dst + 2 * TC * 64) = make_float4(o_b[0], o_b[1], o_b[2], o_b[3]); *(float4*)(dst + 2 * TC * 64 + 4) = make_float4(o_b[4], o_b[5], o_b[6], o_b[7]);
        *(float4*)(dst + 3 * TC * 64) = make_float4(o_kd[0], o_kd[1], o_kd[2], o_kd[3]); *(float4*)(dst + 3 * TC * 64 + 4) = make_float4(o_kd[4], o_kd[5], o_kd[6], o_kd[7]);
        *(float4*)(dst + 4 * TC * 64) = make_float4(r[0], r[1], r[2], r[3]); *(float4*)(dst + 4 * TC * 64 + 4) = make_float4(r[4], r[5], r[6], r[7]);
        *(float4*)(dst + 5 * TC * 64) = make_float4(v[0], v[1], v[2], v[3]); *(float4*)(dst + 5 * TC * 64 + 4) = make_float4(v[4], v[5], v[6], v[7]);
      }
      __syncthreads();
    }
    if (wave < 4) {
      float y = rows_allreduce(scan_dot(S, r_prev));
      if (lane < 16) P[(tok0 + t_prev) * LDP + ycol + wave * 16 + lane] = (u16)(pack2(y, 0.f) & 0xffff);
    }
  }
}

__device__ __forceinline__ void ph_post(int l) {
  const KP p = kparams();
  u16* P = (u16*)(p->ws + WS_P);
  const u16* gate = (const u16*)(p->ws + WS_GATE);
  const int tid_ = otid();
  const int wave = tid_ >> 6, lane = tid_ & 63;
  const int c0 = lane * 8;
  const float* mup = p->in[I_MUP] + (size_t)l * 1920;
  const float* mun = p->in[I_MUN] + (size_t)l * 1920;
  const float* gng = p->in[I_GNG] + (size_t)l * 512 + c0;
  const float* gnb = p->in[I_GNB] + (size_t)l * 512 + c0;
  const float* rkp = p->in[I_RK] + (size_t)l * 512 + c0;
  for (int t = blockIdx.x * 8 + wave; t < NT; t += gridDim.x * 8) {
    const int s = t & (SEQ - 1);
    const u16* row = P + (size_t)t * LDP;
    float y[8], f[8];
    { uint4 q = *(const uint4*)(row + PC_U + c0); unpack8(q, y); }
    { uint4 q = *(const uint4*)(row + PC_V + c0); unpack8(q, f); }
    float sum = 0.f;
#pragma unroll
    for (int e = 0; e < 8; ++e) { y[e] += f[e]; sum += y[e]; }
    sum = xor_sum(sum, 1); sum = xor_sum(sum, 2); sum = xor_sum(sum, 4);
    const float mu = sum * (1.0f / 64.0f);
    float var = 0.f;
#pragma unroll
    for (int e = 0; e < 8; ++e) { float dd = y[e] - mu; var += dd * dd; }
    var = xor_sum(var, 1); var = xor_sum(var, 2); var = xor_sum(var, 4);
    const float rs = rsqrtf(var * (1.0f / 64.0f) + 64e-5f);
    float rr[8], kk[8], vv[8], tmp[8], tp[8], tn[8];
#pragma unroll
    for (int which = 0; which < 3; ++which) {
      const int col = PC_R + which * 512 + c0;
      uint4 q = *(const uint4*)(row + col);
      unpack8(q, tmp);
      if (s > 0) { uint4 a = *(const uint4*)(row - LDP + col); unpack8(a, tp); }
      else {
#pragma unroll
        for (int e = 0; e < 8; ++e) tp[e] = 0.f;
      }
      if (s < SEQ - 1) { uint4 a = *(const uint4*)(row + LDP + col); unpack8(a, tn); }
      else {
#pragma unroll
        for (int e = 0; e < 8; ++e) tn[e] = 0.f;
      }
#pragma unroll
      for (int e = 0; e < 8; ++e) {
        float z = tmp[e] + mup[which * 512 + c0 + e] * (tp[e] - tmp[e]) + mun[which * 512 + c0 + e] * (tn[e] - tmp[e]);
        if (which == 0) rr[e] = z; else if (which == 1) kk[e] = z; else vv[e] = z;
      }
    }
    float bs = 0.f;
#pragma unroll
    for (int e = 0; e < 8; ++e) bs += rr[e] * kk[e] * rkp[e];
    bs = xor_sum(bs, 1); bs = xor_sum(bs, 2); bs = xor_sum(bs, 4);
    float gt[8], o[8];
    { uint4 q = *(const uint4*)(gate + (size_t)t * 512 + c0); unpack8(q, gt); }
#pragma unroll
    for (int e = 0; e < 8; ++e) o[e] = ((y[e] - mu) * rs * gng[e] + gnb[e] + bs * vv[e]) * gt[e];
    *(uint4*)(P + (size_t)t * LDP + PC_U + c0) = pack8(o);
  }
}

__device__ __forceinline__ void run_phase(int ph, unsigned char* smem) {
  const KP p = kparams();
  u16* wb = (u16*)(p->ws + WS_WB);
  u16* xn = (u16*)(p->ws + WS_XN);
  u16* P = (u16*)(p->ws + WS_P);
  u16* merged = (u16*)(p->ws + WS_PREP);
  u16* hid = (u16*)(p->ws + WS_P);
  if (ph == 0) {
    ph_convert(0, smem);
    ph_ln(p->in[I_X], p->in[I_LN0G], p->in[I_LN0B], p->out, xn);
    return;
  }
  const int l = (ph - 1) / 12, k = (ph - 1) % 12;
  switch (k) {
    case 0: ph_gemm<EPI_BF16>(xn, 1024, wb + WO_IN, 1024, 1024, 3968, P, LDP, (u16*)smem); break;
    case 1: ph_attn(l, smem); break;
    case 2: ph_poolmix_lr(l); break;
    case 3: ph_prep_gemm(l, (u16*)smem); break;
    case 4: ph_scan(l, smem); break;
    case 5: ph_post(l); break;
    case 6: ph_merge(l, (u16*)smem); break;
    case 7: ph_gemm<EPI_RES>(merged, 1024, wb + WO_OUT, 1024, 1024, 1024, p->out, 1024, (u16*)smem); break;
    case 8: ph_ln(p->out, p->in[I_LN1G] + (size_t)l * 1024, p->in[I_LN1B] + (size_t)l * 1024, p->out, xn); break;
    case 9: ph_gemm<EPI_RELU2>(xn, 1024, wb + WO_UP, 1024, 1024, 4096, hid, 4096, (u16*)smem); break;
    case 10: ph_gemm<EPI_RES>(hid, 4096, wb + WO_DOWN, 4096, 4096, 1024, p->out, 1024, (u16*)smem); break;
    case 11:
      ph_ln(p->out, p->in[I_LN2G] + (size_t)l * 1024, p->in[I_LN2B] + (size_t)l * 1024, p->out, xn);
      if (l + 1 < DEPTH) ph_convert(l + 1, smem);
      break;
  }
}

constexpr int N_PHASES = 1 + 12 * DEPTH;

__global__ void __launch_bounds__(NTHREADS) mega(Params p_unused) {
  extern __shared__ __attribute__((aligned(16))) unsigned char smem[];
  const KP kp = kparams();
  if (kp->ph_hi - kp->ph_lo == 1) {
    run_phase(kp->ph_lo, smem);
  } else {
    cg::grid_group grid = cg::this_grid();
    grid.sync();
    unsigned* bar = (unsigned*)(kp->ws + WS_BAR);
    unsigned target = 0;
    const int ph_hi = kp->ph_hi;
    for (int ph = kp->ph_lo; ph < ph_hi; ++ph) {
      run_phase(ph, smem);
      if (ph + 1 < ph_hi) {
        target += gridDim.x;
        asm volatile("s_waitcnt vmcnt(0)" ::: "memory");
        __syncthreads();
        if (otid() == 0) {
          __builtin_amdgcn_fence(__ATOMIC_RELEASE, "agent");
          asm volatile("s_waitcnt vmcnt(0)" ::: "memory");
          __hip_atomic_fetch_add(bar, 1u, __ATOMIC_RELAXED, __HIP_MEMORY_SCOPE_AGENT);
          while (__hip_atomic_load(bar, __ATOMIC_RELAXED, __HIP_MEMORY_SCOPE_AGENT) < target) __builtin_amdgcn_s_sleep(1);
          __builtin_amdgcn_fence(__ATOMIC_ACQUIRE, "agent");
          asm volatile("s_waitcnt vmcnt(0)" ::: "memory");
        }
        __syncthreads();
      }
    }
  }
}

extern "C" void kernel_launch(void* const* d_in, const int* in_sizes, int n_in, void* d_out, int out_size, void* d_ws, size_t ws_size, hipStream_t stream) {
  static int grid_blocks = 0;
  if (!grid_blocks) {
    if (n_in != N_IN || ws_size < WS_END) { fprintf(stderr, "kernel_launch: unexpected n_in %d / ws %zu\n", n_in, ws_size); grid_blocks = -1; return; }
    int dev = 0, cus = 0, per_cu = 0;
    (void)hipGetDevice(&dev);
    (void)hipDeviceGetAttribute(&cus, hipDeviceAttributeMultiprocessorCount, dev);
    if (hipFuncSetAttribute((const void*)mega, hipFuncAttributeMaxDynamicSharedMemorySize, LDS_BYTES) != hipSuccess) fprintf(stderr, "hipFuncSetAttribute failed\n");
    (void)hipOccupancyMaxActiveBlocksPerMultiprocessor(&per_cu, (const void*)mega, NTHREADS, LDS_BYTES);
    if (per_cu < 1) { fprintf(stderr, "occupancy query says %d\n", per_cu); per_cu = 1; }
    grid_blocks = cus;
  }
  if (grid_blocks < 0) return;
  Params p{};
  for (int i = 0; i < N_IN; ++i) p.in[i] = (const float*)d_in[i];
  p.out = (float*)d_out;
  p.ws = (unsigned char*)d_ws;
#if MULTI_LAUNCH
  for (int ph = 0; ph < N_PHASES; ++ph) {
    p.ph_lo = ph; p.ph_hi = ph + 1;
    hipLaunchKernelGGL(mega, dim3(grid_blocks), dim3(NTHREADS), LDS_BYTES, stream, p);
  }
#else
  (void)hipMemsetAsync((unsigned char*)d_ws + WS_BAR, 0, 256, stream);
  p.ph_lo = 0; p.ph_hi = N_PHASES;
  void* args[] = {&p};
  hipError_t e = hipLaunchCooperativeKernel((void*)mega, dim3(grid_blocks), dim3(NTHREADS), args, LDS_BYTES, stream);
  if (e != hipSuccess) fprintf(stderr, "cooperative launch failed: %s (grid %d)\n", hipGetErrorString(e), grid_blocks);
#endif
}
```

```cpp
#include <hip/hip_runtime.h>
#include <hip/hip_cooperative_groups.h>
#include <cstdio>
namespace cg = cooperative_groups;

typedef unsigned short u16;
typedef __attribute__((ext_vector_type(8))) _Float16 bf16x8;
typedef __attribute__((ext_vector_type(4))) float f32x4;
typedef __bf16 bf2_t __attribute__((ext_vector_type(2)));
typedef float fl2_t __attribute__((ext_vector_type(2)));
typedef _Float16 h2_t __attribute__((ext_vector_type(2)));

#ifndef MULTI_LAUNCH
#define MULTI_LAUNCH 0
#endif

constexpr int SEQ = 2048, DM = 1024, NT = 16 * 2048, DEPTH = 4;
constexpr int LDP = 3968;
constexpr int PC_U = 0, PC_Q = 512, PC_K = 1024, PC_V = 1536, PC_R = 2048, PC_RK = 2560, PC_RV = 3072, PC_LW = 3584;
constexpr int NTHREADS = 512;
constexpr int LSTR = 72;
constexpr size_t MiB = 1048576;
constexpr size_t WS_WB = 0, WS_XN = 36 * MiB, WS_P = 100 * MiB, WS_PREP = 348 * MiB, WS_GATE = 476 * MiB, WS_BAR = 508 * MiB, WS_END = 508 * MiB + 16384;
constexpr size_t WO_IN = 0, WO_POOL = WO_IN + 7040 * 1024, WO_W2 = WO_POOL + 65536, WO_A2 = WO_W2 + 65536, WO_G2 = WO_A2 + 65536,
                 WO_BR = WO_G2 + 65536, WO_OUT = WO_BR + 3 * 1024 * 512, WO_UP = WO_OUT + 1024 * 1024, WO_DOWN = WO_UP + 4096 * 1024;
constexpr int LDS_BYTES = 131072 + 4 * 4608;

enum { I_X = 0, I_LN0G, I_LN0B, I_WIN, I_POOLW, I_POOLS, I_LAM, I_SUBG, I_REL, I_MUP, I_MUN, I_W0, I_W2, I_A0, I_A2, I_G2, I_KK, I_KA, I_RK,
       I_GNG, I_GNB, I_WBR, I_BG, I_WOUT, I_LN1G, I_LN1B, I_WUP, I_WDOWN, I_LN2G, I_LN2B, N_IN };

struct Params {
  const float* in[N_IN];
  float* out;
  unsigned char* ws;
  int ph_lo, ph_hi;
};

typedef __attribute__((address_space(4))) const Params* KP;
__device__ __forceinline__ KP kparams() { KP k = (KP)__builtin_amdgcn_kernarg_segment_ptr(); asm volatile("" : "+s"(k)); return k; }

__device__ __forceinline__ unsigned pack2(float a, float b) { fl2_t v = {a, b}; h2_t h = __builtin_convertvector(v, h2_t); return __builtin_bit_cast(unsigned, h); }
__device__ __forceinline__ unsigned packh2(float a, float b) { fl2_t v = {a, b}; h2_t h = __builtin_convertvector(v, h2_t); return __builtin_bit_cast(unsigned, h); }
__device__ __forceinline__ float bflo(unsigned u) { return __uint_as_float(u << 16); }
__device__ __forceinline__ float bfhi(unsigned u) { return __uint_as_float(u & 0xffff0000u); }
__device__ __forceinline__ void unpack8(const uint4& q, float* f) {
  h2_t a = __builtin_bit_cast(h2_t, q.x), b = __builtin_bit_cast(h2_t, q.y), c = __builtin_bit_cast(h2_t, q.z), d = __builtin_bit_cast(h2_t, q.w);
  f[0] = (float)a[0]; f[1] = (float)a[1]; f[2] = (float)b[0]; f[3] = (float)b[1]; f[4] = (float)c[0]; f[5] = (float)c[1]; f[6] = (float)d[0]; f[7] = (float)d[1];
}
__device__ __forceinline__ void unpackh8(const uint4& q, float* f) {
  h2_t a = __builtin_bit_cast(h2_t, q.x), b = __builtin_bit_cast(h2_t, q.y), c = __builtin_bit_cast(h2_t, q.z), d = __builtin_bit_cast(h2_t, q.w);
  f[0] = (float)a[0]; f[1] = (float)a[1]; f[2] = (float)b[0]; f[3] = (float)b[1]; f[4] = (float)c[0]; f[5] = (float)c[1]; f[6] = (float)d[0]; f[7] = (float)d[1];
}
__device__ __forceinline__ uint4 pack8(const float* f) { return make_uint4(pack2(f[0], f[1]), pack2(f[2], f[3]), pack2(f[4], f[5]), pack2(f[6], f[7])); }
__device__ __forceinline__ float sigmoidf_(float x) { return __builtin_amdgcn_rcpf(1.0f + __expf(-x)); }
__device__ __forceinline__ int otid() { int t = threadIdx.x; asm volatile("" : "+v"(t)); return t; }
__device__ __forceinline__ float tanh_fast(float x) { const float e = __expf(2.0f * x); return 1.0f - 2.0f * __builtin_amdgcn_rcpf(1.0f + e); }
template <int CTRL> __device__ __forceinline__ float dpp_f(float x) { return __builtin_bit_cast(float, __builtin_amdgcn_update_dpp(0, __builtin_bit_cast(int, x), CTRL, 0xf, 0xf, true)); }
__device__ __forceinline__ float xor_sum(float v, int m) { return v + __shfl_xor(v, m); }

__device__ __forceinline__ void conv_tile(const float* __restrict__ src, int K, int N, u16* __restrict__ dst, int tile, float* sm) {
  const int tid = otid();
  const int tn = N >> 6;
  const int k0 = (tile / tn) * 64, n0 = (tile % tn) * 64;
#pragma unroll
  for (int i = 0; i < 2; ++i) {
    int r = (tid >> 4) + i * 32, c = (tid & 15) * 4;
    float4 v = *(const float4*)(src + (size_t)(k0 + r) * N + n0 + c);
    sm[r * 65 + c] = v.x; sm[r * 65 + c + 1] = v.y; sm[r * 65 + c + 2] = v.z; sm[r * 65 + c + 3] = v.w;
  }
  __syncthreads();
  {
    int n = tid >> 3, kc = (tid & 7) * 8;
    float f[8];
#pragma unroll
    for (int j = 0; j < 8; ++j) f[j] = sm[(kc + j) * 65 + n];
    *(uint4*)(dst + (size_t)(n0 + n) * K + k0 + kc) = pack8(f);
  }
  __syncthreads();
}

__device__ __forceinline__ void ph_convert(int l, unsigned char* smem) {
  const KP p = kparams();
  u16* wb = (u16*)(p->ws + WS_WB);
  float* sm = (float*)smem;
  for (int job = 0; job < 16; ++job) {
    const float* src; int K, N; u16* dst;
    if (job == 0) { src = p->in[I_WIN] + (size_t)l * 1024 * 7040; K = 1024; N = 7040; dst = wb + WO_IN; }
    else if (job < 5) { int g = job - 1; src = p->in[I_POOLW] + ((size_t)l * 4 + g) * 16384; K = 128; N = 128; dst = wb + WO_POOL + g * 16384; }
    else if (job < 7) { int d = job - 5; src = p->in[I_W2] + ((size_t)l * 2 + d) * 64 * 512; K = 64; N = 512; dst = wb + WO_W2 + d * 32768; }
    else if (job < 9) { int d = job - 7; src = p->in[I_A2] + ((size_t)l * 2 + d) * 64 * 512; K = 64; N = 512; dst = wb + WO_A2 + d * 32768; }
    else if (job == 9) { src = p->in[I_G2] + (size_t)l * 128 * 512; K = 128; N = 512; dst = wb + WO_G2; }
    else if (job < 13) { int n = job - 10; src = p->in[I_WBR] + ((size_t)l * 3 + n) * 512 * 1024; K = 512; N = 1024; dst = wb + WO_BR + (size_t)n * 1024 * 512; }
    else if (job == 13) { src = p->in[I_WOUT] + (size_t)l * 1024 * 1024; K = 1024; N = 1024; dst = wb + WO_OUT; }
    else if (job == 14) { src = p->in[I_WUP] + (size_t)l * 1024 * 4096; K = 1024; N = 4096; dst = wb + WO_UP; }
    else { src = p->in[I_WDOWN] + (size_t)l * 4096 * 1024; K = 4096; N = 1024; dst = wb + WO_DOWN; }
    int ntile = (K >> 6) * (N >> 6);
    for (int t = blockIdx.x; t < ntile; t += gridDim.x) conv_tile(src, K, N, dst, t, sm);
  }
}

template <int IN32, int OUT32>
__device__ __forceinline__ void ph_ln(const float* inf, const float* __restrict__ g, const float* __restrict__ b, float* outf, u16* xb) {
  const int tid_ = otid();
  const int wave = tid_ >> 6, lane = tid_ & 63;
#pragma unroll 2
  for (int row = blockIdx.x * 8 + wave; row < NT; row += gridDim.x * 8) {
    float v[16];
    if (IN32) {
      const float4* src = (const float4*)(inf + (size_t)row * DM);
#pragma unroll
      for (int hh = 0; hh < 2; ++hh) {
        float4 a = src[hh * 128 + lane * 2], c = src[hh * 128 + lane * 2 + 1];
        v[hh * 8 + 0] = a.x; v[hh * 8 + 1] = a.y; v[hh * 8 + 2] = a.z; v[hh * 8 + 3] = a.w;
        v[hh * 8 + 4] = c.x; v[hh * 8 + 5] = c.y; v[hh * 8 + 6] = c.z; v[hh * 8 + 7] = c.w;
      }
    } else {
#pragma unroll
      for (int hh = 0; hh < 2; ++hh) { uint4 q = *(const uint4*)(xb + (size_t)row * DM + hh * 512 + lane * 8); unpack8(q, v + hh * 8); }
    }
    float s = 0.f;
#pragma unroll
    for (int i = 0; i < 16; ++i) s += v[i];
#pragma unroll
    for (int m = 1; m < 64; m <<= 1) s = xor_sum(s, m);
    const float mu = s * (1.0f / DM);
    float q2 = 0.f;
#pragma unroll
    for (int i = 0; i < 16; ++i) { const float dd = v[i] - mu; q2 += dd * dd; }
#pragma unroll
    for (int m = 1; m < 64; m <<= 1) q2 = xor_sum(q2, m);
    const float rs = rsqrtf(q2 * (1.0f / DM) + 1e-5f);
#pragma unroll
    for (int hh = 0; hh < 2; ++hh) {
      const int c0 = hh * 512 + lane * 8;
      float o[8];
      const float4 g0 = *(const float4*)(g + c0), g1 = *(const float4*)(g + c0 + 4), b0 = *(const float4*)(b + c0), b1 = *(const float4*)(b + c0 + 4);
      o[0] = (v[hh * 8 + 0] - mu) * rs * g0.x + b0.x; o[1] = (v[hh * 8 + 1] - mu) * rs * g0.y + b0.y;
      o[2] = (v[hh * 8 + 2] - mu) * rs * g0.z + b0.z; o[3] = (v[hh * 8 + 3] - mu) * rs * g0.w + b0.w;
      o[4] = (v[hh * 8 + 4] - mu) * rs * g1.x + b1.x; o[5] = (v[hh * 8 + 5] - mu) * rs * g1.y + b1.y;
      o[6] = (v[hh * 8 + 6] - mu) * rs * g1.z + b1.z; o[7] = (v[hh * 8 + 7] - mu) * rs * g1.w + b1.w;
      if (OUT32) {
        float4* dst = (float4*)(outf + (size_t)row * DM + c0);
        dst[0] = make_float4(o[0], o[1], o[2], o[3]); dst[1] = make_float4(o[4], o[5], o[6], o[7]);
      } else {
        *(uint4*)(xb + (size_t)row * DM + c0) = pack8(o);
      }
    }
  }
}

template <int TM>
__device__ __forceinline__ void gemm_kloop(f32x4 (&acc)[TM][4], const u16* __restrict__ A, int lda, const u16* __restrict__ Bt, int ldb, int K, u16* smem) {
  constexpr int BM = TM * 64;
  u16* sA = smem;
  u16* sB = smem + 2 * BM * LSTR;
  const int tid = otid(), lane = tid & 63, wave = tid >> 6, wm = wave >> 1, wn = wave & 1;
  const int lr = tid >> 3, lc = (tid & 7) * 8;
  uint4 ra0, ra1, ra2 = make_uint4(0, 0, 0, 0), ra3 = make_uint4(0, 0, 0, 0), rb0, rb1;
  const u16* ga = A + (size_t)lr * lda + lc;
  const u16* gb = Bt + (size_t)lr * ldb + lc;
#define GLOAD(k0)                                                                      \
  ra0 = *(const uint4*)(ga + (k0));                                                    \
  ra1 = *(const uint4*)(ga + (size_t)64 * lda + (k0));                                 \
  if (TM > 2) { ra2 = *(const uint4*)(ga + (size_t)128 * lda + (k0)); ra3 = *(const uint4*)(ga + (size_t)192 * lda + (k0)); } \
  rb0 = *(const uint4*)(gb + (k0));                                                    \
  rb1 = *(const uint4*)(gb + (size_t)64 * ldb + (k0));
#define SWRITE(bb)                                                                     \
  *(uint4*)(sA + ((bb) * BM + lr) * LSTR + lc) = ra0;                                  \
  *(uint4*)(sA + ((bb) * BM + lr + 64) * LSTR + lc) = ra1;                             \
  if (TM > 2) { *(uint4*)(sA + ((bb) * BM + lr + 128) * LSTR + lc) = ra2; *(uint4*)(sA + ((bb) * BM + lr + 192) * LSTR + lc) = ra3; } \
  *(uint4*)(sB + ((bb) * 128 + lr) * LSTR + lc) = rb0;                                 \
  *(uint4*)(sB + ((bb) * 128 + lr + 64) * LSTR + lc) = rb1;
  GLOAD(0)
  SWRITE(0)
  __syncthreads();
  int KT = K >> 6;
  asm volatile("" : "+s"(KT));
  for (int kt = 0; kt < KT; ++kt) {
    const int buf = kt & 1;
    if (kt + 1 < KT) {
      const int k0 = (kt + 1) * 64;
      GLOAD(k0)
    }
    const u16* a_base = sA + (buf * BM + wm * TM * 16 + (lane & 15)) * LSTR + (lane >> 4) * 8;
    const u16* b_base = sB + (buf * 128 + wn * 64 + (lane & 15)) * LSTR + (lane >> 4) * 8;
#pragma unroll
    for (int ks = 0; ks < 2; ++ks) {
      bf16x8 af[TM], bfr[4];
#pragma unroll
      for (int tm = 0; tm < TM; ++tm) af[tm] = *(const bf16x8*)(a_base + tm * 16 * LSTR + ks * 32);
#pragma unroll
      for (int tn = 0; tn < 4; ++tn) bfr[tn] = *(const bf16x8*)(b_base + tn * 16 * LSTR + ks * 32);
#pragma unroll
      for (int tm = 0; tm < TM; ++tm)
#pragma unroll
        for (int tn = 0; tn < 4; ++tn) acc[tm][tn] = __builtin_amdgcn_mfma_f32_16x16x32_f16(bfr[tn], af[tm], acc[tm][tn], 0, 0, 0);
    }
    if (kt + 1 < KT) {
      const int nb = buf ^ 1;
      SWRITE(nb)
    }
    __syncthreads();
  }
}

template <int TM>
__device__ __forceinline__ void zero_acc(f32x4 (&acc)[TM][4]) {
#pragma unroll
  for (int tm = 0; tm < TM; ++tm)
#pragma unroll
    for (int tn = 0; tn < 4; ++tn) acc[tm][tn] = f32x4{0.f, 0.f, 0.f, 0.f};
}

__device__ __forceinline__ void gemm_kloop256(f32x4 (&acc)[8][4], const u16* __restrict__ A, int lda, const u16* __restrict__ Bt, int ldb, int K, u16* smem) {
  uint4* sA = (uint4*)smem;
  uint4* sB = sA + 2 * 8 * 256;
  const int tid = otid(), lane = tid & 63, wave = tid >> 6, wm = wave >> 2, wn = wave & 3;
  const int lr = tid >> 3, kcw = tid & 7, lc = kcw * 8;
  uint4 qa0, qa1, qa2, qa3, qb0, qb1, qb2, qb3;
  const int rho_ = lr & 31, bperm_ = (lr & 32) + 8 * ((rho_ & 15) >> 2) + 4 * (rho_ >> 4) + (rho_ & 3);
  const unsigned oa = (unsigned)(lr * lda + lc), ob = (unsigned)(bperm_ * ldb + lc);
  const unsigned sa64 = (unsigned)(64 * lda), sb64 = (unsigned)(64 * ldb);
#define GLOAD2(k0)                                       \
  qa0 = *(const uint4*)(A + (oa + (unsigned)(k0)));                      \
  qa1 = *(const uint4*)(A + (oa + sa64 + (unsigned)(k0)));               \
  qa2 = *(const uint4*)(A + (oa + 2 * sa64 + (unsigned)(k0)));           \
  qa3 = *(const uint4*)(A + (oa + 3 * sa64 + (unsigned)(k0)));           \
  qb0 = *(const uint4*)(Bt + (ob + (unsigned)(k0)));                     \
  qb1 = *(const uint4*)(Bt + (ob + sb64 + (unsigned)(k0)));              \
  qb2 = *(const uint4*)(Bt + (ob + 2 * sb64 + (unsigned)(k0)));          \
  qb3 = *(const uint4*)(Bt + (ob + 3 * sb64 + (unsigned)(k0)));
  const int wofs = kcw * 256 + (lr ^ kcw);
#define SWRITE2(bb)                          \
  sA[(bb) * 2048 + wofs] = qa0;              \
  sA[(bb) * 2048 + wofs + 64] = qa1;         \
  sA[(bb) * 2048 + wofs + 128] = qa2;        \
  sA[(bb) * 2048 + wofs + 192] = qa3;        \
  sB[(bb) * 2048 + wofs] = qb0;              \
  sB[(bb) * 2048 + wofs + 64] = qb1;         \
  sB[(bb) * 2048 + wofs + 128] = qb2;        \
  sB[(bb) * 2048 + wofs + 192] = qb3;
  int KT = K >> 6;
  asm volatile("" : "+s"(KT));
  GLOAD2(0)
  SWRITE2(0)
  if (KT > 1) { GLOAD2(64) }
  __syncthreads();
  const int l15 = lane & 15, g = lane >> 4;
  for (int kt = 0; kt < KT; ++kt) {
    const int buf = kt & 1;
    {
      const uint4* a0p = sA + buf * 2048 + (0 * 4 + g) * 256 + wm * 128 + (l15 ^ (0 * 4 + g));
      const uint4* a1p = sA + buf * 2048 + (1 * 4 + g) * 256 + wm * 128 + (l15 ^ (1 * 4 + g));
      const uint4* b0p = sB + buf * 2048 + (0 * 4 + g) * 256 + wn * 64 + (l15 ^ (0 * 4 + g));
      const uint4* b1p = sB + buf * 2048 + (1 * 4 + g) * 256 + wn * 64 + (l15 ^ (1 * 4 + g));
      bf16x8 bA[4], fA[4], fB[4];
#define LDF4(dst, ptr, o) _Pragma("unroll") for (int i_ = 0; i_ < 4; ++i_) dst[i_] = __builtin_bit_cast(bf16x8, (ptr)[((o) + i_) * 16]);
#define MM16(AF, BF, hf_) { __builtin_amdgcn_s_setprio(1); _Pragma("unroll") for (int tm = 0; tm < 4; ++tm) _Pragma("unroll") for (int tn = 0; tn < 4; ++tn) \
    acc[(hf_) * 4 + tm][tn] = __builtin_amdgcn_mfma_f32_16x16x32_f16(BF[tn], AF[tm], acc[(hf_) * 4 + tm][tn], 0, 0, 0); __builtin_amdgcn_s_setprio(0); }
      LDF4(bA, b0p, 0) LDF4(fA, a0p, 0)
      LDF4(fB, a0p, 4)
      __builtin_amdgcn_sched_barrier(0);
      MM16(fA, bA, 0)
      __builtin_amdgcn_sched_barrier(0);
      LDF4(fA, a1p, 0)
      __builtin_amdgcn_sched_barrier(0);
      MM16(fB, bA, 1)
      __builtin_amdgcn_sched_barrier(0);
      LDF4(bA, b1p, 0) LDF4(fB, a1p, 4)
      __builtin_amdgcn_sched_barrier(0);
      if (kt + 1 < KT) {
        const int nb = buf ^ 1;
        SWRITE2(nb)
        if (kt + 2 < KT) {
          const int k0 = (kt + 2) * 64;
          GLOAD2(k0)
        }
      }
      __builtin_amdgcn_sched_barrier(0);
      MM16(fA, bA, 0)
      __builtin_amdgcn_sched_barrier(0);
      MM16(fB, bA, 1)
    }
    __syncthreads();
  }
}

__device__ __forceinline__ void gemm_kloopS(f32x4 (&acc)[4][4], const u16* __restrict__ A, int lda, const u16* __restrict__ Bt, int ldb, int K, u16* smem) {
  uint4* sA = (uint4*)smem;
  uint4* sB = sA + 2 * 8 * 256;
  const int tid = otid(), lane = tid & 63, wave = tid >> 6, wm = wave >> 1, wn = wave & 1;
  const int lr = tid >> 3, kcw = tid & 7, lc = kcw * 8;
  uint4 qa0, qa1, qa2, qa3, qb0, qb1;
  const int rho_ = lr & 31, bperm_ = (lr & 32) + 8 * ((rho_ & 15) >> 2) + 4 * (rho_ >> 4) + (rho_ & 3);
  const unsigned oa = (unsigned)(lr * lda + lc), ob = (unsigned)(bperm_ * ldb + lc);
  const unsigned sa64 = (unsigned)(64 * lda), sb64 = (unsigned)(64 * ldb);
#define GLOAD3(k0)                                                       \
  qa0 = *(const uint4*)(A + (oa + (unsigned)(k0)));                      \
  qa1 = *(const uint4*)(A + (oa + sa64 + (unsigned)(k0)));               \
  qa2 = *(const uint4*)(A + (oa + 2 * sa64 + (unsigned)(k0)));           \
  qa3 = *(const uint4*)(A + (oa + 3 * sa64 + (unsigned)(k0)));           \
  qb0 = *(const uint4*)(Bt + (ob + (unsigned)(k0)));                     \
  qb1 = *(const uint4*)(Bt + (ob + sb64 + (unsigned)(k0)));
  const int wofa = kcw * 256 + (lr ^ kcw), wofb = kcw * 128 + (lr ^ kcw);
#define SWRITE3(bb)                          \
  sA[(bb) * 2048 + wofa] = qa0;              \
  sA[(bb) * 2048 + wofa + 64] = qa1;         \
  sA[(bb) * 2048 + wofa + 128] = qa2;        \
  sA[(bb) * 2048 + wofa + 192] = qa3;        \
  sB[(bb) * 1024 + wofb] = qb0;              \
  sB[(bb) * 1024 + wofb + 64] = qb1;
  int KT = K >> 6;
  asm volatile("" : "+s"(KT));
  GLOAD3(0)
  SWRITE3(0)
  if (KT > 1) { GLOAD3(64) }
  __syncthreads();
  const int l15 = lane & 15, g = lane >> 4;
  for (int kt = 0; kt < KT; ++kt) {
    const int buf = kt & 1;
    {
      const uint4* a0p = sA + buf * 2048 + (0 * 4 + g) * 256 + wm * 64 + (l15 ^ (0 * 4 + g));
      const uint4* a1p = sA + buf * 2048 + (1 * 4 + g) * 256 + wm * 64 + (l15 ^ (1 * 4 + g));
      const uint4* b0p = sB + buf * 1024 + (0 * 4 + g) * 128 + wn * 64 + (l15 ^ (0 * 4 + g));
      const uint4* b1p = sB + buf * 1024 + (1 * 4 + g) * 128 + wn * 64 + (l15 ^ (1 * 4 + g));
      bf16x8 bA[4], fA[4];
#define MM16S(AF, BF) _Pragma("unroll") for (int tm = 0; tm < 4; ++tm) _Pragma("unroll") for (int tn = 0; tn < 4; ++tn) \
    acc[tm][tn] = __builtin_amdgcn_mfma_f32_16x16x32_f16(BF[tn], AF[tm], acc[tm][tn], 0, 0, 0);
      LDF4(bA, b0p, 0) LDF4(fA, a0p, 0)
      __builtin_amdgcn_sched_barrier(0);
      MM16S(fA, bA)
      __builtin_amdgcn_sched_barrier(0);
      LDF4(bA, b1p, 0) LDF4(fA, a1p, 0)
      __builtin_amdgcn_sched_barrier(0);
      if (kt + 1 < KT) {
        const int nb = buf ^ 1;
        SWRITE3(nb)
        if (kt + 2 < KT) {
          const int k0 = (kt + 2) * 64;
          GLOAD3(k0)
        }
      }
      __builtin_amdgcn_sched_barrier(0);
      MM16S(fA, bA)
    }
    __syncthreads();
  }
}

__device__ __forceinline__ bool tile_sched(int it, int tiles_m, int tiles_n, int& mt, int& nt, bool& valid) {
  const int pnw = tiles_n >= 8 ? 8 : tiles_n;
  const int pmh = 32 / pnw;
  const int pn_cnt = (tiles_n + pnw - 1) / pnw, pm_cnt = tiles_m / pmh;
  const int npatch = pn_cnt * pm_cnt;
  const int g8 = gridDim.x >> 3;
  const int xcd = blockIdx.x & 7, j = blockIdx.x >> 3;
  const int slots_per_round = g8;
  long slot = (long)it * slots_per_round + j;
  int patch_local = (int)(slot >> 5), w = (int)(slot & 31);
  int patch = patch_local * 8 + xcd;
  if (patch >= npatch) return false;
  int pnn = patch % pn_cnt, pmm = patch / pn_cnt;
  mt = pmm * pmh + (w % pmh);
  nt = pnn * pnw + (w / pmh);
  valid = (nt < tiles_n);
  return true;
}

enum { EPI_BF16 = 0, EPI_RES = 1, EPI_RELU2 = 2 };

template <int EPI>
__device__ __forceinline__ void ph_gemm(const u16* A, int lda, const u16* Bt, int ldb, int K, int N, void* Cout, int ldc, u16* smem) {
  const int tid_ = otid();
  const int lane = tid_ & 63, wave = tid_ >> 6, wm = wave >> 1, wn = wave & 1;
  const int tiles_m = NT / 256, tiles_n = N / 128;
  for (int it = 0;; ++it) {
    int mt, nt; bool valid;
    if (!tile_sched(it, tiles_m, tiles_n, mt, nt, valid)) break;
    if (!valid) continue;
    f32x4 acc[4][4];
    zero_acc<4>(acc);
    gemm_kloop<4>(acc, A + (size_t)mt * 256 * lda, lda, Bt + (size_t)nt * 128 * ldb, ldb, K, smem);
#pragma unroll
    for (int tm = 0; tm < 4; ++tm) {
      const int m = mt * 256 + wm * 64 + tm * 16 + (lane & 15);
#pragma unroll
      for (int tn = 0; tn < 4; ++tn) {
        const int n = nt * 128 + wn * 64 + tn * 16 + (lane >> 4) * 4;
        f32x4 a = acc[tm][tn];
        if (EPI == EPI_BF16) {
          *(uint2*)((u16*)Cout + (size_t)m * ldc + n) = make_uint2(pack2(a[0], a[1]), pack2(a[2], a[3]));
        } else if (EPI == EPI_RELU2) {
          float r0 = fmaxf(a[0], 0.f), r1 = fmaxf(a[1], 0.f), r2 = fmaxf(a[2], 0.f), r3 = fmaxf(a[3], 0.f);
          *(uint2*)((u16*)Cout + (size_t)m * ldc + n) = make_uint2(pack2(r0 * r0, r1 * r1), pack2(r2 * r2, r3 * r3));
        } else {
          uint2* px = (uint2*)((u16*)Cout + (size_t)m * ldc + n);
          const uint2 xr = *px;
          const h2_t x01 = __builtin_bit_cast(h2_t, xr.x), x23 = __builtin_bit_cast(h2_t, xr.y);
          const float al = 1.681792830507429f;
          *px = make_uint2(pack2(al * (float)x01[0] + a[0], al * (float)x01[1] + a[1]), pack2(al * (float)x23[0] + a[2], al * (float)x23[1] + a[3]));
        }
      }
    }
  }
}

template <int EPI>
__device__ __forceinline__ void ph_gemm256(const u16* A, int lda, const u16* Bt, int ldb, int K, int N, void* Cout, int ldc, u16* smem) {
  const int tid_ = otid();
  const int lane = tid_ & 63, wave = tid_ >> 6, wm = wave >> 2, wn = wave & 3;
  const int tiles_m = NT / 256, tiles_n = (N + 255) / 256;
  for (int it = 0;; ++it) {
    int mt, nt; bool valid;
    if (!tile_sched(it, tiles_m, tiles_n, mt, nt, valid)) break;
    if (!valid) continue;
    f32x4 acc[8][4];
#pragma unroll
    for (int tm = 0; tm < 8; ++tm)
#pragma unroll
      for (int tn = 0; tn < 4; ++tn) acc[tm][tn] = f32x4{0.f, 0.f, 0.f, 0.f};
    gemm_kloop256(acc, A + (size_t)mt * 256 * lda, lda, Bt + (size_t)nt * 256 * ldb, ldb, K, smem);
#pragma unroll
    for (int tm = 0; tm < 8; ++tm) {
      const int m = mt * 256 + wm * 128 + tm * 16 + (lane & 15);
#pragma unroll
      for (int q2 = 0; q2 < 2; ++q2) {
        const int n = nt * 256 + wn * 64 + q2 * 32 + (lane >> 4) * 8;
        if (n >= N) continue;
        const f32x4 a = acc[tm][2 * q2], c = acc[tm][2 * q2 + 1];
        uint4* px = (uint4*)((u16*)Cout + (size_t)m * ldc + n);
        if (EPI == EPI_BF16) {
          *px = make_uint4(pack2(a[0], a[1]), pack2(a[2], a[3]), pack2(c[0], c[1]), pack2(c[2], c[3]));
        } else if (EPI == EPI_RELU2) {
          const float r0 = fmaxf(a[0], 0.f), r1 = fmaxf(a[1], 0.f), r2 = fmaxf(a[2], 0.f), r3 = fmaxf(a[3], 0.f);
          const float r4 = fmaxf(c[0], 0.f), r5 = fmaxf(c[1], 0.f), r6 = fmaxf(c[2], 0.f), r7 = fmaxf(c[3], 0.f);
          *px = make_uint4(pack2(r0 * r0, r1 * r1), pack2(r2 * r2, r3 * r3), pack2(r4 * r4, r5 * r5), pack2(r6 * r6, r7 * r7));
        } else {
          const uint4 xr = *px;
          float xf[8];
          unpack8(xr, xf);
          const float al = 1.681792830507429f;
          *px = make_uint4(pack2(al * xf[0] + a[0], al * xf[1] + a[1]), pack2(al * xf[2] + a[2], al * xf[3] + a[3]),
                           pack2(al * xf[4] + c[0], al * xf[5] + c[1]), pack2(al * xf[6] + c[2], al * xf[7] + c[3]));
        }
      }
    }
  }
}

__device__ __forceinline__ void ph_prep_gemm(int l, u16* smem) {
  const KP p = kparams();
  const int tid_ = otid();
  const int lane = tid_ & 63, wave = tid_ >> 6, wm = wave >> 1, wn = wave & 1;
  u16* P = (u16*)(p->ws + WS_P);
  const u16* wb = (const u16*)(p->ws + WS_WB);
  u16* prepE = (u16*)(p->ws + WS_PREP);
  u16* prepA = prepE + (size_t)2 * NT * 512;
  u16* gate = (u16*)(p->ws + WS_GATE);
  const int total = 512 + 5 * 512;
  for (int t = blockIdx.x; t < total; t += gridDim.x) {
    int job, mt, nt;
    if (t < 512) { job = t & 3; mt = t >> 2; nt = 0; }
    else { int t2 = t - 512; job = 4 + (t2 >> 9); int r = t2 & 511; nt = r & 3; mt = r >> 2; }
    const u16 *A, *Bt; int K, ldb;
    const u16* mixb = (const u16*)p->out;
    const u16* lrb = mixb + (size_t)NT * 512;
    int lda;
    if (job < 4) { A = mixb + job * 128; lda = 512; Bt = wb + WO_POOL + job * 16384; K = 128; ldb = 128; }
    else if (job < 6) { int d = job - 4; A = lrb + d * 64; lda = 384; Bt = wb + WO_W2 + d * 32768; K = 64; ldb = 64; }
    else if (job < 8) { int d = job - 6; A = lrb + 128 + d * 64; lda = 384; Bt = wb + WO_A2 + d * 32768; K = 64; ldb = 64; }
    else { A = lrb + 256; lda = 384; Bt = wb + WO_G2; K = 128; ldb = 128; }
    f32x4 acc[4][4];
    zero_acc<4>(acc);
    gemm_kloopS(acc, A + (size_t)mt * 256 * lda, lda, Bt + (size_t)nt * 128 * ldb, ldb, K, smem);
#pragma unroll
    for (int tm = 0; tm < 4; ++tm) {
      const int m = mt * 256 + wm * 64 + tm * 16 + (lane & 15);
#pragma unroll
      for (int q2 = 0; q2 < 2; ++q2) {
        const int n = nt * 128 + wn * 64 + q2 * 32 + (lane >> 4) * 8;
        const f32x4 a = acc[tm][2 * q2], c = acc[tm][2 * q2 + 1];
        float v8[8] = {a[0], a[1], a[2], a[3], c[0], c[1], c[2], c[3]};
        if (job < 4) {
          const float4 s0 = *(const float4*)(p->in[I_POOLS] + (size_t)l * 512 + job * 128 + n), s1 = *(const float4*)(p->in[I_POOLS] + (size_t)l * 512 + job * 128 + n + 4);
          v8[0] *= s0.x; v8[1] *= s0.y; v8[2] *= s0.z; v8[3] *= s0.w; v8[4] *= s1.x; v8[5] *= s1.y; v8[6] *= s1.z; v8[7] *= s1.w;
          *(uint4*)(P + (size_t)m * LDP + PC_K + job * 128 + n) = pack8(v8);
        } else if (job < 6) {
          const int d = job - 4;
          const float* w0p = p->in[I_W0] + ((size_t)l * 2 + d) * 512 + n;
          const float4 s0 = *(const float4*)w0p, s1 = *(const float4*)(w0p + 4);
          const float cc = 0.6065306597126334f;
          v8[0] = cc * sigmoidf_(s0.x + v8[0]); v8[1] = cc * sigmoidf_(s0.y + v8[1]); v8[2] = cc * sigmoidf_(s0.z + v8[2]); v8[3] = cc * sigmoidf_(s0.w + v8[3]);
          v8[4] = cc * sigmoidf_(s1.x + v8[4]); v8[5] = cc * sigmoidf_(s1.y + v8[5]); v8[6] = cc * sigmoidf_(s1.z + v8[6]); v8[7] = cc * sigmoidf_(s1.w + v8[7]);
          *(uint4*)(prepE + ((size_t)d * NT + m) * 512 + n) = pack8(v8);
        } else if (job < 8) {
          const int d = job - 6;
          const float* a0p = p->in[I_A0] + ((size_t)l * 2 + d) * 512 + n;
          const float4 s0 = *(const float4*)a0p, s1 = *(const float4*)(a0p + 4);
          v8[0] = sigmoidf_(s0.x + v8[0]); v8[1] = sigmoidf_(s0.y + v8[1]); v8[2] = sigmoidf_(s0.z + v8[2]); v8[3] = sigmoidf_(s0.w + v8[3]);
          v8[4] = sigmoidf_(s1.x + v8[4]); v8[5] = sigmoidf_(s1.y + v8[5]); v8[6] = sigmoidf_(s1.z + v8[6]); v8[7] = sigmoidf_(s1.w + v8[7]);
          *(uint4*)(prepA + ((size_t)d * NT + m) * 512 + n) = pack8(v8);
        } else {
          *(uint4*)(gate + (size_t)m * 512 + n) = pack8(v8);
        }
      }
    }
  }
}

__device__ __forceinline__ void ph_merge(int l, u16* smem) {
  const KP p = kparams();
  const int tid_ = otid();
  const int lane = tid_ & 63, wave = tid_ >> 6, wm = wave >> 1, wn = wave & 1;
  const u16* P = (const u16*)(p->ws + WS_P);
  const u16* xn = (const u16*)(p->ws + WS_XN);
  const u16* wb = (const u16*)(p->ws + WS_WB);
  u16* merged = (u16*)(p->ws + WS_PREP);
  const float* bg = p->in[I_BG] + (size_t)l * 3 * 1024;
  const int tiles_m = NT / 256, tiles_n = 8;
  for (int it = 0;; ++it) {
    int mt, nt; bool valid;
    if (!tile_sched(it, tiles_m, tiles_n, mt, nt, valid)) break;
    if (!valid) continue;
    int NB3 = 3;
    asm volatile("" : "+s"(NB3));
    for (int nb = 0; nb < NB3; ++nb) {
      uint2 gt[4][4];
      {
        f32x4 accG[4][4];
        zero_acc<4>(accG);
        gemm_kloopS(accG, xn + (size_t)mt * 256 * 1024, 1024, wb + WO_IN + (size_t)(3968 + nb * 1024 + nt * 128) * 1024, 1024, 1024, smem);
#pragma unroll
        for (int tn = 0; tn < 4; ++tn) {
          const int n = nt * 128 + wn * 64 + (tn >> 1) * 32 + (lane >> 4) * 8 + (tn & 1) * 4;
          const float4 b4 = *(const float4*)(bg + nb * 1024 + n);
#pragma unroll
          for (int tm = 0; tm < 4; ++tm)
            gt[tm][tn] = make_uint2(pack2(sigmoidf_(accG[tm][tn][0] + b4.x), sigmoidf_(accG[tm][tn][1] + b4.y)),
                                    pack2(sigmoidf_(accG[tm][tn][2] + b4.z), sigmoidf_(accG[tm][tn][3] + b4.w)));
        }
      }
      f32x4 accB[4][4];
      zero_acc<4>(accB);
      const int col = (nb == 0) ? PC_K : (nb == 1 ? PC_Q : PC_U);
      gemm_kloopS(accB, P + (size_t)mt * 256 * LDP + col, LDP, wb + WO_BR + (size_t)(nb * 1024 + nt * 128) * 512, 512, 512, smem);
      unsigned obase = (unsigned)((mt * 256 + wm * 64 + (lane & 15)) * 1024 + nt * 128 + wn * 64 + (lane >> 4) * 8);
      asm volatile("" : "+v"(obase));
#pragma unroll
      for (int tm = 0; tm < 4; ++tm) {
#pragma unroll
        for (int q2 = 0; q2 < 2; ++q2) {
          uint4* dst = (uint4*)(merged + (obase + (unsigned)(tm * 16 * 1024 + q2 * 32)));
          float mf[8] = {0.f, 0.f, 0.f, 0.f, 0.f, 0.f, 0.f, 0.f};
          if (nb > 0) { const uint4 prev = *dst; unpack8(prev, mf); }
          const h2_t g01 = __builtin_bit_cast(h2_t, gt[tm][2 * q2].x), g23 = __builtin_bit_cast(h2_t, gt[tm][2 * q2].y);
          const h2_t g45 = __builtin_bit_cast(h2_t, gt[tm][2 * q2 + 1].x), g67 = __builtin_bit_cast(h2_t, gt[tm][2 * q2 + 1].y);
          const f32x4 ba = accB[tm][2 * q2], bc = accB[tm][2 * q2 + 1];
          *dst = make_uint4(pack2(mf[0] + (float)g01[0] * ba[0], mf[1] + (float)g01[1] * ba[1]), pack2(mf[2] + (float)g23[0] * ba[2], mf[3] + (float)g23[1] * ba[3]),
                            pack2(mf[4] + (float)g45[0] * bc[0], mf[5] + (float)g45[1] * bc[1]), pack2(mf[6] + (float)g67[0] * bc[2], mf[7] + (float)g67[1] * bc[3]));
        }
      }
    }
  }
}

__device__ __forceinline__ int rel_bucket_dev(int rel) {
  int n = rel < 0 ? -rel : rel;
  int b;
  if (n < 8) b = n; else if (n < 12) b = 8; else if (n < 16) b = 9; else if (n < 23) b = 10; else if (n < 32) b = 11;
  else if (n < 46) b = 12; else if (n < 64) b = 13; else if (n < 91) b = 14; else b = 15;
  return b + (rel > 0 ? 16 : 0);
}

__device__ __forceinline__ void ph_attn(int l, unsigned char* smem_raw, bool dummy_out) {
  const KP p = kparams();
  constexpr int KSTR = 136, VSTR = 72;
  u16* sK = (u16*)smem_raw;
  u16* sVt = sK + 2 * 64 * KSTR;
  float* lut = (float*)(sVt + 2 * 128 * VSTR);
  u16* P = (u16*)(p->ws + WS_P);
  const int tid = otid(), lane = tid & 63, wave = tid >> 6, g = lane >> 4, l15 = lane & 15;
  const float LOG2E = 1.4426950408889634f;
  const float* lf = p->in[I_LAM] + (size_t)l * 256;
  float s01 = lf[lane] * lf[64 + lane], s23 = lf[128 + lane] * lf[192 + lane];
#pragma unroll
  for (int m = 1; m < 64; m <<= 1) { s01 = xor_sum(s01, m); s23 = xor_sum(s23, m); }
  const float lam_init = 0.8f - 0.6f * __expf(-0.3f * (float)l);
  const float lam = __expf(s01) - __expf(s23) + lam_init;
  const float* relb = p->in[I_REL];
  const float* subg = p->in[I_SUBG] + (size_t)l * 128;
  const int g8 = gridDim.x >> 3, xcd = blockIdx.x & 7, jb = blockIdx.x >> 3;
  for (int it = 0;; ++it) {
    const int unit = (it * 8 + xcd) * g8 + jb;
    if (it * 8 * g8 >= 1024) break;
    if (unit >= 1024) continue;
    const int b = unit >> 6, h = (unit >> 4) & 3, qb = unit & 15;
    const size_t tok0 = (size_t)b * SEQ;
    __syncthreads();
    if (tid < 257) lut[tid] = relb[rel_bucket_dev(tid - 128) * 4 + h] * LOG2E;
    const float bias_far_neg = relb[15 * 4 + h] * LOG2E, bias_far_pos = relb[31 * 4 + h] * LOG2E;
    const int qpos = qb * 128 + wave * 16 + l15;
    bf16x8 qf[2][2];
    {
      const u16* qp = P + (tok0 + qpos) * LDP + PC_Q + h * 128 + g * 8;
#pragma unroll
      for (int mp = 0; mp < 2; ++mp)
#pragma unroll
        for (int ks = 0; ks < 2; ++ks) qf[mp][ks] = *(const bf16x8*)(qp + mp * 64 + ks * 32);
    }
    f32x4 O[2][8];
#pragma unroll
    for (int mp = 0; mp < 2; ++mp)
#pragma unroll
      for (int d = 0; d < 8; ++d) O[mp][d] = f32x4{0.f, 0.f, 0.f, 0.f};
    float mrow[2] = {-1e30f, -1e30f}, lrow[2] = {0.f, 0.f};
    const u16* kg = P + (tok0 + (tid >> 4)) * LDP + PC_K + h * 128 + (tid & 15) * 8;
    const u16* vg = P + (tok0 + lane) * LDP + PC_V + h * 128 + wave * 16;
    uint4 rk0, rk1, rv0, rv1;
    rk0 = *(const uint4*)(kg); rk1 = *(const uint4*)(kg + (size_t)32 * LDP); rv0 = *(const uint4*)(vg); rv1 = *(const uint4*)(vg + 8);
#define VST(vd, rv)                                                                   \
  vd[0 * VSTR] = (u16)(rv.x & 0xffff); vd[1 * VSTR] = (u16)(rv.x >> 16);              \
  vd[2 * VSTR] = (u16)(rv.y & 0xffff); vd[3 * VSTR] = (u16)(rv.y >> 16);              \
  vd[4 * VSTR] = (u16)(rv.z & 0xffff); vd[5 * VSTR] = (u16)(rv.z >> 16);              \
  vd[6 * VSTR] = (u16)(rv.w & 0xffff); vd[7 * VSTR] = (u16)(rv.w >> 16);
#define STAGE(bb)                                                                     \
  {                                                                                   \
    *(uint4*)(sK + ((bb) * 64 + (tid >> 4)) * KSTR + (tid & 15) * 8) = rk0;           \
    *(uint4*)(sK + ((bb) * 64 + (tid >> 4) + 32) * KSTR + (tid & 15) * 8) = rk1;      \
    u16* vd0 = sVt + ((bb) * 128 + wave * 16) * VSTR + lane;                          \
    u16* vd1 = vd0 + 8 * VSTR;                                                        \
    VST(vd0, rv0) VST(vd1, rv1)                                                       \
  }
    STAGE(0)
    rk0 = *(const uint4*)(kg + ((size_t)64) * LDP);
    rk1 = *(const uint4*)(kg + ((size_t)64 + 32) * LDP);
    rv0 = *(const uint4*)(vg + (size_t)64 * LDP);
    rv1 = *(const uint4*)(vg + (size_t)64 * LDP + 8);
    __syncthreads();
    int NKT = 32;
    asm volatile("" : "+s"(NKT));
    for (int kt = 0; kt < NKT; ++kt) {
      const int buf = kt & 1;
      const int kmin = kt * 64, qmin = qb * 128 + wave * 16;
      const float qs = 0.125f * LOG2E;
      const bool far = (kmin - (qmin + 15) >= 91) || (qmin - (kmin + 63) >= 91);
      const float bfar = (kmin > qmin) ? bias_far_pos : bias_far_neg;
      bf16x8 pf[2][2];
#pragma unroll
      for (int mp = 0; mp < 2; ++mp) {
        f32x4 sc[4];
#pragma unroll
        for (int kk = 0; kk < 4; ++kk) {
          f32x4 a = {0.f, 0.f, 0.f, 0.f};
#pragma unroll
          for (int ks = 0; ks < 2; ++ks) {
            bf16x8 kf = *(const bf16x8*)(sK + (buf * 64 + kk * 16 + l15) * KSTR + mp * 64 + ks * 32 + g * 8);
            a = __builtin_amdgcn_mfma_f32_16x16x32_f16(kf, qf[mp][ks], a, 0, 0, 0);
          }
          sc[kk] = a;
        }
        if (far) {
#pragma unroll
          for (int kk = 0; kk < 4; ++kk)
#pragma unroll
            for (int j = 0; j < 4; ++j) sc[kk][j] = sc[kk][j] * qs + bfar;
        } else {
#pragma unroll
          for (int kk = 0; kk < 4; ++kk)
#pragma unroll
            for (int j = 0; j < 4; ++j) {
              int rel = kmin + kk * 16 + g * 4 + j - qpos;
              rel = rel < -128 ? -128 : (rel > 128 ? 128 : rel);
              sc[kk][j] = sc[kk][j] * qs + lut[rel + 128];
            }
        }
        float mx = sc[0][0];
#pragma unroll
        for (int kk = 0; kk < 4; ++kk)
#pragma unroll
          for (int j = 0; j < 4; ++j) mx = fmaxf(mx, sc[kk][j]);
        mx = fmaxf(mx, __shfl_xor(mx, 16));
        mx = fmaxf(mx, __shfl_xor(mx, 32));
        const float mnew = fmaxf(mrow[mp], mx);
        const float alpha = __builtin_amdgcn_exp2f(mrow[mp] - mnew);
        mrow[mp] = mnew;
        float ps = 0.f;
#pragma unroll
        for (int kk = 0; kk < 4; ++kk)
#pragma unroll
          for (int j = 0; j < 4; ++j) { float ev = __builtin_amdgcn_exp2f(sc[kk][j] - mnew); sc[kk][j] = ev; ps += ev; }
        lrow[mp] = lrow[mp] * alpha + ps;
#pragma unroll
        for (int d = 0; d < 8; ++d) { O[mp][d][0] *= alpha; O[mp][d][1] *= alpha; O[mp][d][2] *= alpha; O[mp][d][3] *= alpha; }
#pragma unroll
        for (int kb = 0; kb < 2; ++kb) {
          uint4 u = make_uint4(pack2(sc[2 * kb][0], sc[2 * kb][1]), pack2(sc[2 * kb][2], sc[2 * kb][3]),
                               pack2(sc[2 * kb + 1][0], sc[2 * kb + 1][1]), pack2(sc[2 * kb + 1][2], sc[2 * kb + 1][3]));
          pf[mp][kb] = __builtin_bit_cast(bf16x8, u);
        }
        __builtin_amdgcn_sched_barrier(0);
      }
      if (kt + 1 < NKT) {
        STAGE(buf ^ 1)
        if (kt + 2 < NKT) {
          rk0 = *(const uint4*)(kg + ((size_t)(kt + 2) * 64) * LDP);
          rk1 = *(const uint4*)(kg + ((size_t)(kt + 2) * 64 + 32) * LDP);
          rv0 = *(const uint4*)(vg + (size_t)(kt + 2) * 64 * LDP);
          rv1 = *(const uint4*)(vg + (size_t)(kt + 2) * 64 * LDP + 8);
        }
      }
      __builtin_amdgcn_sched_barrier(0);
#pragma unroll
      for (int kb = 0; kb < 2; ++kb)
#pragma unroll
        for (int d = 0; d < 8; ++d) {
          const u16* vp = sVt + (buf * 128 + d * 16 + l15) * VSTR + kb * 32 + g * 4;
          uint2 lo = *(const uint2*)vp, hi = *(const uint2*)(vp + 16);
          bf16x8 vf = __builtin_bit_cast(bf16x8, make_uint4(lo.x, lo.y, hi.x, hi.y));
          O[0][d] = __builtin_amdgcn_mfma_f32_16x16x32_f16(vf, pf[0][kb], O[0][d], 0, 0, 0);
          O[1][d] = __builtin_amdgcn_mfma_f32_16x16x32_f16(vf, pf[1][kb], O[1][d], 0, 0, 0);
          if (d & 1) __builtin_amdgcn_sched_barrier(0);
        }
      __syncthreads();
    }
    float l0 = lrow[0], l1 = lrow[1];
    l0 = xor_sum(l0, 16); l0 = xor_sum(l0, 32);
    l1 = xor_sum(l1, 16); l1 = xor_sum(l1, 32);
    const float i0 = 1.0f / l0, i1 = lam / l1;
    float ss = 0.f;
#pragma unroll
    for (int d = 0; d < 8; ++d)
#pragma unroll
      for (int j = 0; j < 4; ++j) { float o = O[0][d][j] * i0 - O[1][d][j] * i1; O[0][d][j] = o; ss += o * o; }
    ss = xor_sum(ss, 16); ss = xor_sum(ss, 32);
    const float scl = rsqrtf(ss * (1.0f / 128.0f) + 1e-5f) * (1.0f - lam_init);
    u16* op = dummy_out ? ((u16*)(p->ws + WS_GATE) + (tok0 + qpos) * 512 + h * 128 + g * 4) : (P + (tok0 + qpos) * LDP + PC_Q + h * 128 + g * 4);
#pragma unroll
    for (int d = 0; d < 8; ++d) {
      float4 gg = *(const float4*)(subg + d * 16 + g * 4);
      *(uint2*)(op + d * 16) = make_uint2(pack2(O[0][d][0] * scl * gg.x, O[0][d][1] * scl * gg.y), pack2(O[0][d][2] * scl * gg.z, O[0][d][3] * scl * gg.w));
    }
  }
}

__device__ __forceinline__ void ph_poolmix_lr(int l) {
  const KP p = kparams();
  u16* P = (u16*)(p->ws + WS_P);
  u16* mixb = (u16*)p->out;
  u16* lrb = mixb + (size_t)NT * 512;
  const int tid_ = otid();
  const int wave = tid_ >> 6, lane = tid_ & 63;
  const float* mup = p->in[I_MUP] + (size_t)l * 1920 + 1536;
  const float* mun = p->in[I_MUN] + (size_t)l * 1920 + 1536;
  const int c0 = lane * 8, gi = lane >> 4;
  const int win = 2 << gi, left = win >> 1, right = win - 1 - left;
  float mneg[9], mpos[8];
#pragma unroll
  for (int k = 1; k <= 8; ++k) mneg[k] = (left >= k) ? 1.f : 0.f;
#pragma unroll
  for (int k = 1; k <= 7; ++k) mpos[k] = (right >= k) ? 1.f : 0.f;
  int NRUN = NT / 4;
  asm volatile("" : "+s"(NRUN));
  for (int run = blockIdx.x * 8 + wave; run < NRUN; run += gridDim.x * 8) {
    const int t0 = run * 4, s0 = t0 & (SEQ - 1);
    {
      float acc[4][8];
#pragma unroll
      for (int i = 0; i < 4; ++i)
#pragma unroll
        for (int e = 0; e < 8; ++e) acc[i][e] = 0.f;
      float cm[4], icnt[4];
#pragma unroll
      for (int i = 0; i < 4; ++i) {
        const int s = s0 + i;
        const float cnt = (float)(min(s + right + 1, SEQ) - max(s - left, 0));
        cm[i] = 1.0f - cnt;
        icnt[i] = __builtin_amdgcn_rcpf(cnt);
      }
#pragma unroll
      for (int q = 0; q < 19; ++q) {
        const int rr = s0 - 8 + q;
        uint4 raw = make_uint4(0, 0, 0, 0);
        if (rr >= 0 && rr < SEQ) raw = *(const uint4*)(P + (size_t)(t0 - 8 + q) * LDP + PC_U + c0);
        float f[8];
        unpack8(raw, f);
#pragma unroll
        for (int i = 0; i < 4; ++i) {
          const int dl = q - 8 - i;
          if (dl < -8 || dl > 7) continue;
          const float m = (dl < 0) ? mneg[dl < 0 ? -dl : 1] : (dl > 0 ? mpos[dl > 0 ? dl : 1] : cm[i]);
#pragma unroll
          for (int e = 0; e < 8; ++e) acc[i][e] += m * f[e];
        }
        if (q % 6 == 5) __builtin_amdgcn_sched_barrier(0);
      }
#pragma unroll
      for (int i = 0; i < 4; ++i) {
#pragma unroll
        for (int e = 0; e < 8; ++e) acc[i][e] *= icnt[i];
        *(uint4*)(mixb + (size_t)(t0 + i) * 512 + c0) = pack8(acc[i]);
      }
    }
    if (lane < 48) {
      uint4 raw[6];
#pragma unroll
      for (int q = 0; q < 6; ++q) {
        const int rr = s0 - 1 + q;
        raw[q] = make_uint4(0, 0, 0, 0);
        if (rr >= 0 && rr < SEQ) raw[q] = *(const uint4*)(P + (size_t)(t0 - 1 + q) * LDP + PC_LW + c0);
      }
      float mp[8], mn[8];
#pragma unroll
      for (int e = 0; e < 8; ++e) { mp[e] = mup[c0 + e]; mn[e] = mun[c0 + e]; }
#pragma unroll
      for (int i = 0; i < 4; ++i) {
        float z[8], zp[8], zn[8], o[8];
        unpack8(raw[i], zp); unpack8(raw[i + 1], z); unpack8(raw[i + 2], zn);
#pragma unroll
        for (int e = 0; e < 8; ++e) {
          float v = z[e] + mp[e] * (zp[e] - z[e]) + mn[e] * (zn[e] - z[e]);
          if (c0 < 128) v = tanh_fast(v);
          else if (c0 >= 256) v = sigmoidf_(v);
          o[e] = v;
        }
        *(uint4*)(lrb + (size_t)(t0 + i) * 384 + c0) = pack8(o);
      }
    }
  }
}

#define DPP_ROW(m) " row_newbcast:" #m " row_mask:0xf bank_mask:0xf\n"
__device__ __forceinline__ float scan_dot(const float (&S)[16], float x) {
  float r0, r1, r2, r3;
  asm volatile("s_nop 4\n"
               "v_mul_f32_dpp %0, %20, %4" DPP_ROW(0) "v_mul_f32_dpp %1, %20, %5" DPP_ROW(1) "v_mul_f32_dpp %2, %20, %6" DPP_ROW(2) "v_mul_f32_dpp %3, %20, %7" DPP_ROW(3)
               "v_fmac_f32_dpp %0, %20, %8" DPP_ROW(4) "v_fmac_f32_dpp %1, %20, %9" DPP_ROW(5) "v_fmac_f32_dpp %2, %20, %10" DPP_ROW(6) "v_fmac_f32_dpp %3, %20, %11" DPP_ROW(7)
               "v_fmac_f32_dpp %0, %20, %12" DPP_ROW(8) "v_fmac_f32_dpp %1, %20, %13" DPP_ROW(9) "v_fmac_f32_dpp %2, %20, %14" DPP_ROW(10) "v_fmac_f32_dpp %3, %20, %15" DPP_ROW(11)
               "v_fmac_f32_dpp %0, %20, %16" DPP_ROW(12) "v_fmac_f32_dpp %1, %20, %17" DPP_ROW(13) "v_fmac_f32_dpp %2, %20, %18" DPP_ROW(14) "v_fmac_f32_dpp %3, %20, %19" DPP_ROW(15)
               : "=&v"(r0), "=&v"(r1), "=&v"(r2), "=&v"(r3)
               : "v"(S[0]), "v"(S[1]), "v"(S[2]), "v"(S[3]), "v"(S[4]), "v"(S[5]), "v"(S[6]), "v"(S[7]), "v"(S[8]), "v"(S[9]), "v"(S[10]), "v"(S[11]),
                 "v"(S[12]), "v"(S[13]), "v"(S[14]), "v"(S[15]), "v"(x));
  return (r0 + r1) + (r2 + r3);
}
#define UPD_B(i) "v_fmac_f32_dpp %" #i ", %16, %18" DPP_ROW(i)
#define UPD_K(i) "v_fmac_f32_dpp %" #i ", %17, %19" DPP_ROW(i)
#define ALL16(M) M(0) M(1) M(2) M(3) M(4) M(5) M(6) M(7) M(8) M(9) M(10) M(11) M(12) M(13) M(14) M(15)
__device__ __forceinline__ void scan_rank2(fl2_t (&S2)[8], float b, float kd, float sa, float v) {
  asm volatile("s_nop 4\n" ALL16(UPD_B) ALL16(UPD_K)
               : "+v"(S2[0][0]), "+v"(S2[0][1]), "+v"(S2[1][0]), "+v"(S2[1][1]), "+v"(S2[2][0]), "+v"(S2[2][1]), "+v"(S2[3][0]), "+v"(S2[3][1]),
                 "+v"(S2[4][0]), "+v"(S2[4][1]), "+v"(S2[5][0]), "+v"(S2[5][1]), "+v"(S2[6][0]), "+v"(S2[6][1]), "+v"(S2[7][0]), "+v"(S2[7][1])
               : "v"(b), "v"(kd), "v"(sa), "v"(v));
}
__device__ __forceinline__ float rows_allreduce(float x) {
  f32x4 z = {0.f, 0.f, 0.f, 0.f};
  f32x4 r = __builtin_amdgcn_mfma_f32_16x16x4f32(1.0f, x, z, 0, 0, 0);
  return r[0];
}

typedef __attribute__((ext_vector_type(8))) short s16x8;
__device__ __forceinline__ unsigned pack2bf(float a, float b) { fl2_t v = {a, b}; bf2_t h = __builtin_convertvector(v, bf2_t); return __builtin_bit_cast(unsigned, h); }
__device__ __forceinline__ s16x8 mk8(uint2 lo, uint2 hi) { return __builtin_bit_cast(s16x8, make_uint4(lo.x, lo.y, hi.x, hi.y)); }
__device__ __forceinline__ uint2 cvt4bf(f32x4 a) { return make_uint2(pack2bf(a[0], a[1]), pack2bf(a[2], a[3])); }
__device__ __forceinline__ f32x4 mmbf(s16x8 a, s16x8 b, f32x4 c) { return __builtin_amdgcn_mfma_f32_16x16x32_bf16(a, b, c, 0, 0, 0); }
__device__ __forceinline__ f32x4 mm16(f32x4 PT, f32x4 Q) {
  const uint2 z = make_uint2(0, 0);
  return mmbf(mk8(cvt4bf(PT), z), mk8(cvt4bf(Q), z), f32x4{0.f, 0.f, 0.f, 0.f});
}
constexpr int CB_KKT = 0, CB_RT = 2304, CB_WT = 4608, CB_VBT = 9728, CB_CC = 12800, CB_AN1 = 13056, CB_AT = 13824, CB_AY = 14592, CB_SIZE = 16384;
constexpr int CB_BH = CB_WT, CB_KH = CB_WT + 2304;

__device__ __forceinline__ void ph_scan(int l, unsigned char* smem_raw) {
  const KP p = kparams();
  u16* P = (u16*)(p->ws + WS_P);
  const u16* prepE = (const u16*)(p->ws + WS_PREP);
  const u16* prepA = prepE + (size_t)2 * NT * 512;
  const int tid = otid(), wave = tid >> 6, lane = tid & 63, l15 = lane & 15, g = lane >> 4;
  const uint2 z2 = make_uint2(0, 0);
  for (int chain = blockIdx.x; chain < 256; chain += gridDim.x) {
    const int b = chain >> 4, h = (chain >> 1) & 7, d = chain & 1;
    const size_t tok0 = (size_t)b * SEQ;
    const int ycol = (d == 0 ? PC_U : PC_V) + h * 64;
    f32x4 ST[4];
#pragma unroll
    for (int jt = 0; jt < 4; ++jt) ST[jt] = f32x4{0.f, 0.f, 0.f, 0.f};
    __syncthreads();
    int NG = SEQ / 64;
    asm volatile("" : "+s"(NG));
#define HLD3(dst, o_, which_, chn_, tp_, row_)                                                                                  \
  dst[(o_) + 0] = *(const uint4*)((row_) + PC_R + (which_) * 512 + (chn_));                                                      \
  dst[(o_) + 1] = ((tp_) > 0) ? *(const uint4*)((row_) - LDP + PC_R + (which_) * 512 + (chn_)) : make_uint4(0, 0, 0, 0);         \
  dst[(o_) + 2] = ((tp_) < SEQ - 1) ? *(const uint4*)((row_) + LDP + PC_R + (which_) * 512 + (chn_)) : make_uint4(0, 0, 0, 0);
    for (int gi = 0; gi <= NG; ++gi) {
      if (wave < 4) {
        if (gi >= 1) {
          int NC4 = 4;
          asm volatile("" : "+s"(NC4));
          for (int cc = 0; cc < NC4; ++cc) {
            const unsigned char* cb = smem_raw + (((gi - 1) & 1) * 4 + cc) * CB_SIZE;
            const u16* kkt = (const u16*)(cb + CB_KKT) + l15 * 72 + g * 4;
            const u16* rt = (const u16*)(cb + CB_RT) + l15 * 72 + g * 4;
            const u16* vbt = (const u16*)(cb + CB_VBT) + (wave * 16 + l15) * 24 + g * 4;
            const s16x8 sb0 = mk8(cvt4bf(ST[0]), cvt4bf(ST[1])), sb1 = mk8(cvt4bf(ST[2]), cvt4bf(ST[3]));
            const uint2 vq = *(const uint2*)vbt;
            f32x4 UT = mmbf(mk8(*(const uint2*)(kkt), *(const uint2*)(kkt + 16)), sb0, f32x4{0.f, 0.f, 0.f, 0.f});
            UT = mmbf(mk8(*(const uint2*)(kkt + 32), *(const uint2*)(kkt + 48)), sb1, UT);
            UT = mmbf(mk8(*(const uint2*)((const u16*)(cb + CB_AN1) + l15 * 24 + g * 4), z2), mk8(vq, z2), UT);
            f32x4 SAT = mmbf(mk8(*(const uint2*)((const u16*)(cb + CB_AT) + l15 * 24 + g * 4), z2), mk8(cvt4bf(UT), z2), f32x4{0.f, 0.f, 0.f, 0.f});
            const s16x8 bsv = mk8(cvt4bf(SAT), vq);
            f32x4 YT = mmbf(mk8(*(const uint2*)(rt), *(const uint2*)(rt + 16)), sb0, f32x4{0.f, 0.f, 0.f, 0.f});
            YT = mmbf(mk8(*(const uint2*)(rt + 32), *(const uint2*)(rt + 48)), sb1, YT);
            YT = mmbf(*(const s16x8*)((const u16*)(cb + CB_AY) + l15 * 40 + g * 8), bsv, YT);
#pragma unroll
            for (int jt = 0; jt < 4; ++jt) {
              const float4 c4 = *(const float4*)((const float*)(cb + CB_CC) + jt * 16 + g * 4);
              f32x4 sc = ST[jt];
              sc[0] *= c4.x; sc[1] *= c4.y; sc[2] *= c4.z; sc[3] *= c4.w;
              ST[jt] = mmbf(*(const s16x8*)((const u16*)(cb + CB_WT) + (jt * 16 + l15) * 40 + g * 8), bsv, sc);
            }
            const int step0 = ((gi - 1) * 4 + cc) * 16 + g * 4;
#pragma unroll
            for (int r = 0; r < 4; ++r) {
              const int step = step0 + r;
              const int tp = d ? (SEQ - 1 - step) : step;
              P[(tok0 + tp) * LDP + ycol + wave * 16 + l15] = (u16)(pack2(YT[r], 0.f) & 0xffff);
            }
          }
        }
      } else if (gi < NG) {
        unsigned char* cb = smem_raw + ((gi & 1) * 4 + (wave - 4)) * CB_SIZE;
        const int t = lane & 15, cg = lane >> 4, ch0 = cg * 16;
        const float* mup = p->in[I_MUP] + (size_t)l * 1920;
        const float* mun = p->in[I_MUN] + (size_t)l * 1920;
        const float* kkp = p->in[I_KK] + (size_t)l * 512 + h * 64 + ch0;
        const float* kap = p->in[I_KA] + (size_t)l * 512 + h * 64 + ch0;
        unsigned char* hs = smem_raw + 8 * CB_SIZE + (wave - 4) * 4608;
        const int step = (gi * 4 + (wave - 4)) * 16 + t;
        const int tp = d ? (SEQ - 1 - step) : step;
        uint4 HL0[11], K1[3], R1[8];
        {
          const u16* row_ = P + (tok0 + tp) * LDP;
          const int chn0_ = h * 64 + ch0, chn1_ = chn0_ + 8;
          HLD3(HL0, 3, 1, chn0_, tp, row_) HLD3(K1, 0, 1, chn1_, tp, row_)
          HLD3(HL0, 0, 0, chn0_, tp, row_) HLD3(HL0, 6, 2, chn0_, tp, row_)
          HL0[9] = *(const uint4*)(prepE + ((size_t)d * NT + tok0 + tp) * 512 + chn0_);
          HL0[10] = *(const uint4*)(prepA + ((size_t)d * NT + tok0 + tp) * 512 + chn0_);
          HLD3(R1, 0, 0, chn1_, tp, row_) HLD3(R1, 3, 2, chn1_, tp, row_)
          R1[6] = *(const uint4*)(prepE + ((size_t)d * NT + tok0 + tp) * 512 + chn1_);
          R1[7] = *(const uint4*)(prepA + ((size_t)d * NT + tok0 + tp) * 512 + chn1_);
        }
        float nrm = 0.f;
#pragma unroll
        for (int hh = 0; hh < 2; ++hh) {
          const int chn = h * 64 + ch0 + hh * 8;
          float tmp[8], tpv[8], tnv[8];
          if (hh == 0) { unpack8(HL0[3], tmp); unpack8(HL0[4], tpv); unpack8(HL0[5], tnv); }
          else { unpack8(K1[0], tmp); unpack8(K1[1], tpv); unpack8(K1[2], tnv); }
#pragma unroll
          for (int e = 0; e < 8; ++e) {
            float zz = tmp[e] + mup[512 + chn + e] * (tpv[e] - tmp[e]) + mun[512 + chn + e] * (tnv[e] - tmp[e]);
            zz *= kkp[hh * 8 + e];
            nrm += zz * zz;
          }
        }
        nrm = xor_sum(nrm, 16); nrm = xor_sum(nrm, 32);
        const float inv = __builtin_amdgcn_rcpf(fmaxf(sqrtf(nrm), 1e-12f));
#pragma unroll
        for (int hh = 0; hh < 2; ++hh) {
          const int chn = h * 64 + ch0 + hh * 8;
          float rs[8], ks[8], vs[8];
#pragma unroll
          for (int which = 0; which < 3; ++which) {
            float tmp[8], tpv[8], tnv[8];
            if (hh == 0) { unpack8(HL0[which * 3 + 0], tmp); unpack8(HL0[which * 3 + 1], tpv); unpack8(HL0[which * 3 + 2], tnv); }
            else if (which == 1) { unpack8(K1[0], tmp); unpack8(K1[1], tpv); unpack8(K1[2], tnv); }
            else { const int o_ = (which == 0) ? 0 : 3; unpack8(R1[o_ + 0], tmp); unpack8(R1[o_ + 1], tpv); unpack8(R1[o_ + 2], tnv); }
#pragma unroll
            for (int e = 0; e < 8; ++e) {
              float zz = tmp[e] + mup[which * 512 + chn + e] * (tpv[e] - tmp[e]) + mun[which * 512 + chn + e] * (tnv[e] - tmp[e]);
              if (which == 0) rs[e] = zz; else if (which == 1) ks[e] = zz; else vs[e] = zz;
            }
          }
          float ee[8], aa[8];
          if (hh == 0) { unpack8(HL0[9], ee); unpack8(HL0[10], aa); }
          else { unpack8(R1[6], ee); unpack8(R1[7], aa); }
          float o_kk[8], o_r[8], o_bh[8], o_kh[8];
          u16* wt = (u16*)(cb + CB_WT);
          const int sl = (t >> 2) * 8 + (t & 3);
#pragma unroll
          for (int c = 0; c < 8; ++c) {
            float x = ee[c];
            x += dpp_f<0x111>(x); x += dpp_f<0x112>(x); x += dpp_f<0x114>(x); x += dpp_f<0x118>(x);
            const float etot = dpp_f<0x15F>(x);
            const float knc = ks[c] * kkp[hh * 8 + c] * inv;
            const float bb = knc * aa[c];
            const float kd = ks[c] * (1.0f + (aa[c] - 1.0f) * kap[hh * 8 + c]);
            const float up = __expf(x);
            const float dn = __expf(x - etot);
            o_kk[c] = knc * __expf(ee[c] - x);
            o_r[c] = rs[c] * __expf(-x);
            o_bh[c] = bb * up;
            o_kh[c] = kd * up;
            const int j = ch0 + hh * 8 + c;
            wt[j * 40 + sl] = (u16)(pack2bf(bb * dn, 0.f) & 0xffff);
            wt[j * 40 + sl + 4] = (u16)(pack2bf(kd * dn, 0.f) & 0xffff);
            ((u16*)(cb + CB_VBT))[j * 24 + t] = (u16)(pack2bf(vs[c], 0.f) & 0xffff);
            if (t == 15) ((float*)(cb + CB_CC))[j] = __expf(-etot);
          }
#define ST8(ptr, arr) *(uint4*)((u16*)(ptr) + t * 72 + ch0 + hh * 8) = make_uint4(pack2bf(arr[0], arr[1]), pack2bf(arr[2], arr[3]), pack2bf(arr[4], arr[5]), pack2bf(arr[6], arr[7]));
          ST8(cb + CB_KKT, o_kk) ST8(cb + CB_RT, o_r) ST8(hs, o_bh) ST8(hs + 2304, o_kh)
          __builtin_amdgcn_sched_barrier(0);
        }
        f32x4 Nbk = {0.f, 0.f, 0.f, 0.f}, NbkT = Nbk, Nkk = Nbk, Mbr = Nbk, Mkr = Nbk;
#pragma unroll
        for (int ksx = 0; ksx < 2; ++ksx) {
          const int off = l15 * 72 + ksx * 32 + g * 8;
          const s16x8 fb = *(const s16x8*)((const u16*)(hs) + off), fk = *(const s16x8*)((const u16*)(hs + 2304) + off);
          const s16x8 fq = *(const s16x8*)((const u16*)(cb + CB_KKT) + off), fr = *(const s16x8*)((const u16*)(cb + CB_RT) + off);
          Nbk = mmbf(fb, fq, Nbk);
          NbkT = mmbf(fq, fb, NbkT);
          Nkk = mmbf(fk, fq, Nkk);
          Mbr = mmbf(fb, fr, Mbr);
          Mkr = mmbf(fk, fr, Mkr);
        }
#pragma unroll
        for (int r = 0; r < 4; ++r) {
          const int row_ = g * 4 + r;
          if (!(row_ < l15)) { Nbk[r] = 0.f; Nkk[r] = 0.f; }
          if (!(row_ <= l15)) { Mbr[r] = 0.f; Mkr[r] = 0.f; }
          if (!(l15 < row_)) NbkT[r] = 0.f;
        }
        *(uint2*)((u16*)(cb + CB_AN1) + l15 * 24 + g * 4) = cvt4bf(Nkk);
        {
          const uint2 a = cvt4bf(Mbr), bq = cvt4bf(Mkr);
          *(uint4*)((u16*)(cb + CB_AY) + l15 * 40 + g * 8) = make_uint4(a.x, a.y, bq.x, bq.y);
        }
        f32x4 idn;
#pragma unroll
        for (int r = 0; r < 4; ++r) idn[r] = (g * 4 + r == l15) ? 1.f : 0.f;
        const f32x4 N2 = mm16(NbkT, Nbk), N2T = mm16(Nbk, NbkT);
        const f32x4 N4 = mm16(N2T, N2), N4T = mm16(N2, N2T);
        const f32x4 N8 = mm16(N4T, N4);
        const f32x4 Z1 = mm16(idn + N4T, idn + N8);
        const f32x4 Z2 = mm16(idn + N2T, Z1);
        const f32x4 X = mm16(idn - NbkT, Z2);
        *(uint2*)((u16*)(cb + CB_AT) + l15 * 24 + g * 4) = cvt4bf(-X);
      }
      __syncthreads();
    }
  }
}

__device__ __forceinline__ void ph_post(int l) {
  const KP p = kparams();
  u16* P = (u16*)(p->ws + WS_P);
  const u16* gate = (const u16*)(p->ws + WS_GATE);
  const int tid_ = otid();
  const int wave = tid_ >> 6, lane = tid_ & 63;
  const int c0 = lane * 8;
  const float* mup = p->in[I_MUP] + (size_t)l * 1920;
  const float* mun = p->in[I_MUN] + (size_t)l * 1920;
  const float* gng = p->in[I_GNG] + (size_t)l * 512 + c0;
  const float* gnb = p->in[I_GNB] + (size_t)l * 512 + c0;
  const float* rkp = p->in[I_RK] + (size_t)l * 512 + c0;
#pragma unroll 2
  for (int t = blockIdx.x * 8 + wave; t < NT; t += gridDim.x * 8) {
    const int s = t & (SEQ - 1);
    const u16* row = P + (size_t)t * LDP;
    float y[8], f[8];
    { uint4 q = *(const uint4*)(row + PC_U + c0); unpack8(q, y); }
    { uint4 q = *(const uint4*)(row + PC_V + c0); unpack8(q, f); }
    float sum = 0.f;
#pragma unroll
    for (int e = 0; e < 8; ++e) { y[e] += f[e]; sum += y[e]; }
    sum = xor_sum(sum, 1); sum = xor_sum(sum, 2); sum = xor_sum(sum, 4);
    const float mu = sum * (1.0f / 64.0f);
    float var = 0.f;
#pragma unroll
    for (int e = 0; e < 8; ++e) { float dd = y[e] - mu; var += dd * dd; }
    var = xor_sum(var, 1); var = xor_sum(var, 2); var = xor_sum(var, 4);
    const float rs = rsqrtf(var * (1.0f / 64.0f) + 64e-5f);
    float rr[8], kk[8], vv[8], tmp[8], tp[8], tn[8];
#pragma unroll
    for (int which = 0; which < 3; ++which) {
      const int col = PC_R + which * 512 + c0;
      uint4 q = *(const uint4*)(row + col);
      unpack8(q, tmp);
      if (s > 0) { uint4 a = *(const uint4*)(row - LDP + col); unpack8(a, tp); }
      else {
#pragma unroll
        for (int e = 0; e < 8; ++e) tp[e] = 0.f;
      }
      if (s < SEQ - 1) { uint4 a = *(const uint4*)(row + LDP + col); unpack8(a, tn); }
      else {
#pragma unroll
        for (int e = 0; e < 8; ++e) tn[e] = 0.f;
      }
#pragma unroll
      for (int e = 0; e < 8; ++e) {
        float z = tmp[e] + mup[which * 512 + c0 + e] * (tp[e] - tmp[e]) + mun[which * 512 + c0 + e] * (tn[e] - tmp[e]);
        if (which == 0) rr[e] = z; else if (which == 1) kk[e] = z; else vv[e] = z;
      }
    }
    float bs = 0.f;
#pragma unroll
    for (int e = 0; e < 8; ++e) bs += rr[e] * kk[e] * rkp[e];
    bs = xor_sum(bs, 1); bs = xor_sum(bs, 2); bs = xor_sum(bs, 4);
    float gt[8], o[8];
    { uint4 q = *(const uint4*)(gate + (size_t)t * 512 + c0); unpack8(q, gt); }
#pragma unroll
    for (int e = 0; e < 8; ++e) o[e] = ((y[e] - mu) * rs * gng[e] + gnb[e] + bs * vv[e]) * gt[e];
    *(uint4*)(P + (size_t)t * LDP + PC_U + c0) = pack8(o);
  }
}

#define XB_TMO      128
#define XB_XCNT(j)  (256  + 64 * (j))
#define XB_XSUB(j)  (1280 + 64 * (j))
#define XB_XGEN(j)  (2304 + 64 * (j))
#define XB_TOP      3328
#define XB_TOPGEN   3392
#define XCD_BAR_WORDS 3456
#define XB_SPIN_CAP (1u << 18)
#define LAS __attribute__((address_space(3)))

__device__ __forceinline__ unsigned xb_ld(unsigned* p)              { return __hip_atomic_load(p, __ATOMIC_RELAXED, __HIP_MEMORY_SCOPE_AGENT); }
__device__ __forceinline__ unsigned xb_add(unsigned* p, unsigned v) { return __hip_atomic_fetch_add(p, v, __ATOMIC_RELAXED, __HIP_MEMORY_SCOPE_AGENT); }
__device__ __forceinline__ unsigned xb_xcc_id() { return (unsigned)__builtin_amdgcn_s_getreg((3 << 11) | 20) & 0xFu; }
#define XB_SPIN(cond, bar) do { unsigned _sp = 0; while (cond) { __builtin_amdgcn_s_sleep(1); \
    if ((++_sp & 255u) == 0u) { if (xb_ld(&(bar)[XB_TMO])) break; if (_sp > XB_SPIN_CAP) { atomicAdd(&(bar)[XB_TMO], 1u); break; } } } } while (0)

struct XcdBarrier {
    unsigned* bar; unsigned x;
    volatile LAS unsigned* st;
};

__device__ __forceinline__ XcdBarrier xcd_barrier_post(unsigned* bar, volatile LAS unsigned* st) {
    XcdBarrier b; b.bar = bar; b.x = xb_xcc_id(); b.st = st;
    if (threadIdx.x == 0) (void)xb_add(&bar[XB_XCNT(b.x)], 1u);
    return b;
}
__device__ __forceinline__ void xcd_barrier_complete(unsigned* bar, unsigned x, unsigned& nloc, unsigned& nx) {
    const unsigned G = gridDim.x * gridDim.y * gridDim.z;
    unsigned sum, cnt, mine, sp = 0u;
    for (;;) {
        sum = 0u; cnt = 0u; mine = 0u;
#pragma unroll
        for (unsigned j = 0; j < 16; ++j) { const unsigned c = xb_ld(&bar[XB_XCNT(j)]); sum += c; cnt += (c > 0u) ? 1u : 0u; mine = (j == x) ? c : mine; }
        if (sum == G) break;
        __builtin_amdgcn_s_sleep(1);
        if ((++sp & 255u) == 0u) { if (xb_ld(&bar[XB_TMO])) break; if (sp > XB_SPIN_CAP) { atomicAdd(&bar[XB_TMO], 1u); break; } }
    }
    nloc = mine > 0u ? mine : 1u; nx = cnt > 0u ? cnt : 1u;
}

__device__ __forceinline__ void xcd_barrier(const XcdBarrier& b) {
    asm volatile("s_waitcnt vmcnt(0)" ::: "memory");
    __syncthreads();
    if (threadIdx.x == 0) {
        unsigned* bar = b.bar;
        __builtin_amdgcn_s_waitcnt(0);
        unsigned nloc = b.st[0], nx = b.st[1];
        if (nloc == 0u) { xcd_barrier_complete(bar, b.x, nloc, nx); b.st[0] = nloc; b.st[1] = nx; }
        const unsigned old = xb_add(&bar[XB_XSUB(b.x)], 1u);
        const unsigned gen = old / nloc;
        if (old + 1u == (gen + 1u) * nloc) {
            __builtin_amdgcn_fence(__ATOMIC_RELEASE, "agent");
            asm volatile("s_waitcnt vmcnt(0)" ::: "memory");
            const unsigned og = xb_add(&bar[XB_TOP], 1u);
            const unsigned tg = og / nx;
            if (og + 1u == (tg + 1u) * nx) xb_add(&bar[XB_TOPGEN], 1u);
            else XB_SPIN(xb_ld(&bar[XB_TOPGEN]) == tg, bar);
            __builtin_amdgcn_fence(__ATOMIC_ACQUIRE, "agent");
            xb_add(&bar[XB_XGEN(b.x)], 1u);
            asm volatile("s_waitcnt vmcnt(0)" ::: "memory");
        } else {
            XB_SPIN(xb_ld(&bar[XB_XGEN(b.x)]) == gen, bar);
            __builtin_amdgcn_fence(__ATOMIC_ACQUIRE, "agent");
            asm volatile("s_waitcnt vmcnt(0)" ::: "memory");
        }
    }
    __syncthreads();
}

__device__ __forceinline__ void run_phase(int ph, unsigned char* smem) {
  const KP p = kparams();
  u16* wb = (u16*)(p->ws + WS_WB);
  u16* xn = (u16*)(p->ws + WS_XN);
  u16* P = (u16*)(p->ws + WS_P);
  u16* merged = (u16*)(p->ws + WS_PREP);
  u16* hid = (u16*)(p->ws + WS_P);
  if (ph == 0) {
    ph_convert(0, smem);
    ph_ln<1, 0>(p->in[I_X], p->in[I_LN0G], p->in[I_LN0B], p->out, xn);
    return;
  }
  const int l = (ph - 1) / 12, k = (ph - 1) % 12;
#ifndef REPEAT_MASK
#define REPEAT_MASK 0
#endif
  const int nrep = ((REPEAT_MASK >> k) & 1) ? 2 : 1;
  for (int rep = 0; rep < nrep; ++rep)
  switch (k) {
    case 0: ph_gemm256<EPI_BF16>(xn, 1024, wb + WO_IN, 1024, 1024, 3968, P, LDP, (u16*)smem); break;
    case 1:
#ifdef PROBE_ATTN
      ph_attn(l, smem, true);
#endif
      ph_attn(l, smem, false);
      ph_poolmix_lr(l);
      break;
    case 2: break;
    case 3: ph_prep_gemm(l, (u16*)smem); break;
    case 4: ph_scan(l, smem); break;
    case 5: ph_post(l); break;
    case 6: ph_merge(l, (u16*)smem); break;
    case 7: ph_gemm256<EPI_RES>(merged, 1024, wb + WO_OUT, 1024, 1024, 1024, xn, 1024, (u16*)smem); break;
    case 8: ph_ln<0, 0>(p->out, p->in[I_LN1G] + (size_t)l * 1024, p->in[I_LN1B] + (size_t)l * 1024, p->out, xn); break;
    case 9: ph_gemm256<EPI_RELU2>(xn, 1024, wb + WO_UP, 1024, 1024, 4096, hid, 4096, (u16*)smem); break;
    case 10: ph_gemm256<EPI_RES>(hid, 4096, wb + WO_DOWN, 4096, 4096, 1024, xn, 1024, (u16*)smem); break;
    case 11:
      if (l + 1 < DEPTH) ph_ln<0, 0>(p->out, p->in[I_LN2G] + (size_t)l * 1024, p->in[I_LN2B] + (size_t)l * 1024, p->out, xn);
      else ph_ln<0, 1>(p->out, p->in[I_LN2G] + (size_t)l * 1024, p->in[I_LN2B] + (size_t)l * 1024, p->out, xn);
      if (l + 1 < DEPTH) ph_convert(l + 1, smem);
      break;
  }
}

constexpr int N_PHASES = 1 + 12 * DEPTH;

__global__ void __launch_bounds__(NTHREADS) mega(Params p_unused) {
  extern __shared__ __attribute__((aligned(16))) unsigned char smem[];
  const KP kp = kparams();
  if (kp->ph_hi - kp->ph_lo == 1) {
    run_phase(kp->ph_lo, smem);
  } else {
    cg::grid_group grid = cg::this_grid();
    grid.sync();
    unsigned* bar = (unsigned*)(kp->ws + WS_BAR);
    volatile LAS unsigned* xst = (volatile LAS unsigned*)(smem + LDS_BYTES);
    if (otid() == 0) { xst[0] = 0u; xst[1] = 0u; xst[2] = 0u; xst[3] = 0u; }
    __syncthreads();
    XcdBarrier xb = xcd_barrier_post(bar, xst);
    const int ph_hi = kp->ph_hi;
    for (int ph = kp->ph_lo; ph < ph_hi; ++ph) {
      if (ph >= 1 && (ph - 1) % 12 == 2) continue;
      run_phase(ph, smem);
      if (ph + 1 < ph_hi) xcd_barrier(xb);
    }
  }
}

extern "C" void kernel_launch(void* const* d_in, const int* in_sizes, int n_in, void* d_out, int out_size, void* d_ws, size_t ws_size, hipStream_t stream) {
  static int grid_blocks = 0;
  if (!grid_blocks) {
    if (n_in != N_IN || ws_size < WS_END) { fprintf(stderr, "kernel_launch: unexpected n_in %d / ws %zu\n", n_in, ws_size); grid_blocks = -1; return; }
    int dev = 0, cus = 0, per_cu = 0;
    (void)hipGetDevice(&dev);
    (void)hipDeviceGetAttribute(&cus, hipDeviceAttributeMultiprocessorCount, dev);
    if (hipFuncSetAttribute((const void*)mega, hipFuncAttributeMaxDynamicSharedMemorySize, LDS_BYTES + 16) != hipSuccess) fprintf(stderr, "hipFuncSetAttribute failed\n");
    (void)hipOccupancyMaxActiveBlocksPerMultiprocessor(&per_cu, (const void*)mega, NTHREADS, LDS_BYTES + 16);
    if (per_cu < 1) { fprintf(stderr, "occupancy query says %d\n", per_cu); per_cu = 1; }
    grid_blocks = cus;
  }
  if (grid_blocks < 0) return;
  Params p{};
  for (int i = 0; i < N_IN; ++i) p.in[i] = (const float*)d_in[i];
  p.out = (float*)d_out;
  p.ws = (unsigned char*)d_ws;
#if MULTI_LAUNCH
  for (int ph = 0; ph < N_PHASES; ++ph) {
    p.ph_lo = ph; p.ph_hi = ph + 1;
    hipLaunchKernelGGL(mega, dim3(grid_blocks), dim3(NTHREADS), LDS_BYTES + 16, stream, p);
  }
#else
  (void)hipMemsetAsync((unsigned char*)d_ws + WS_BAR, 0, XCD_BAR_WORDS * 4, stream);
  p.ph_lo = 0; p.ph_hi = N_PHASES;
  void* args[] = {&p};
  hipError_t e = hipLaunchCooperativeKernel((void*)mega, dim3(grid_blocks), dim3(NTHREADS), args, LDS_BYTES + 16, stream);
  if (e != hipSuccess) fprintf(stderr, "cooperative launch failed: %s (grid %d)\n", hipGetErrorString(e), grid_blocks);
#endif
}
```

```cpp
#include <hip/hip_runtime.h>
#include <hip/hip_cooperative_groups.h>
#include <cstdio>
namespace cg = cooperative_groups;

typedef unsigned short u16;
typedef __attribute__((ext_vector_type(8))) _Float16 bf16x8;
typedef __attribute__((ext_vector_type(4))) float f32x4;
typedef __bf16 bf2_t __attribute__((ext_vector_type(2)));
typedef float fl2_t __attribute__((ext_vector_type(2)));
typedef _Float16 h2_t __attribute__((ext_vector_type(2)));

#ifndef MULTI_LAUNCH
#define MULTI_LAUNCH 0
#endif

constexpr int SEQ = 2048, DM = 1024, NT = 16 * 2048, DEPTH = 4;
constexpr int LDP = 3968;
constexpr int PC_U = 0, PC_Q = 512, PC_K = 1024, PC_V = 1536, PC_R = 2048, PC_RK = 2560, PC_RV = 3072, PC_LW = 3584;
constexpr int NTHREADS = 512;
constexpr int LSTR = 72;
constexpr size_t MiB = 1048576;
constexpr size_t WS_WB = 0, WS_XN = 36 * MiB, WS_P = 100 * MiB, WS_PREP = 348 * MiB, WS_GATE = 476 * MiB, WS_BAR = 508 * MiB, WS_END = 508 * MiB + 16384;
constexpr size_t WO_IN = 0, WO_POOL = WO_IN + 7040 * 1024, WO_W2 = WO_POOL + 65536, WO_A2 = WO_W2 + 65536, WO_G2 = WO_A2 + 65536,
                 WO_BR = WO_G2 + 65536, WO_OUT = WO_BR + 3 * 1024 * 512, WO_UP = WO_OUT + 1024 * 1024, WO_DOWN = WO_UP + 4096 * 1024;
constexpr int LDS_BYTES = 131072 + 4 * 4608;

enum { I_X = 0, I_LN0G, I_LN0B, I_WIN, I_POOLW, I_POOLS, I_LAM, I_SUBG, I_REL, I_MUP, I_MUN, I_W0, I_W2, I_A0, I_A2, I_G2, I_KK, I_KA, I_RK,
       I_GNG, I_GNB, I_WBR, I_BG, I_WOUT, I_LN1G, I_LN1B, I_WUP, I_WDOWN, I_LN2G, I_LN2B, N_IN };

struct Params {
  const float* in[N_IN];
  float* out;
  unsigned char* ws;
  int ph_lo, ph_hi;
};

typedef __attribute__((address_space(4))) const Params* KP;
__device__ __forceinline__ KP kparams() { KP k = (KP)__builtin_amdgcn_kernarg_segment_ptr(); asm volatile("" : "+s"(k)); return k; }

__device__ __forceinline__ unsigned pack2(float a, float b) { fl2_t v = {a, b}; h2_t h = __builtin_convertvector(v, h2_t); return __builtin_bit_cast(unsigned, h); }
__device__ __forceinline__ unsigned packh2(float a, float b) { fl2_t v = {a, b}; h2_t h = __builtin_convertvector(v, h2_t); return __builtin_bit_cast(unsigned, h); }
__device__ __forceinline__ float bflo(unsigned u) { return __uint_as_float(u << 16); }
__device__ __forceinline__ float bfhi(unsigned u) { return __uint_as_float(u & 0xffff0000u); }
__device__ __forceinline__ void unpack8(const uint4& q, float* f) {
  h2_t a = __builtin_bit_cast(h2_t, q.x), b = __builtin_bit_cast(h2_t, q.y), c = __builtin_bit_cast(h2_t, q.z), d = __builtin_bit_cast(h2_t, q.w);
  f[0] = (float)a[0]; f[1] = (float)a[1]; f[2] = (float)b[0]; f[3] = (float)b[1]; f[4] = (float)c[0]; f[5] = (float)c[1]; f[6] = (float)d[0]; f[7] = (float)d[1];
}
__device__ __forceinline__ void unpackh8(const uint4& q, float* f) {
  h2_t a = __builtin_bit_cast(h2_t, q.x), b = __builtin_bit_cast(h2_t, q.y), c = __builtin_bit_cast(h2_t, q.z), d = __builtin_bit_cast(h2_t, q.w);
  f[0] = (float)a[0]; f[1] = (float)a[1]; f[2] = (float)b[0]; f[3] = (float)b[1]; f[4] = (float)c[0]; f[5] = (float)c[1]; f[6] = (float)d[0]; f[7] = (float)d[1];
}
__device__ __forceinline__ uint4 pack8(const float* f) { return make_uint4(pack2(f[0], f[1]), pack2(f[2], f[3]), pack2(f[4], f[5]), pack2(f[6], f[7])); }
__device__ __forceinline__ float sigmoidf_(float x) { return __builtin_amdgcn_rcpf(1.0f + __expf(-x)); }
__device__ __forceinline__ int otid() { int t = threadIdx.x; asm volatile("" : "+v"(t)); return t; }
__device__ __forceinline__ float tanh_fast(float x) { const float e = __expf(2.0f * x); return 1.0f - 2.0f * __builtin_amdgcn_rcpf(1.0f + e); }
template <int CTRL> __device__ __forceinline__ float dpp_f(float x) { return __builtin_bit_cast(float, __builtin_amdgcn_update_dpp(0, __builtin_bit_cast(int, x), CTRL, 0xf, 0xf, true)); }
__device__ __forceinline__ float xor_sum(float v, int m) { return v + __shfl_xor(v, m); }

__device__ __forceinline__ void conv_tile(const float* __restrict__ src, int K, int N, u16* __restrict__ dst, int tile, float* sm) {
  const int tid = otid();
  const int tn = N >> 6;
  const int k0 = (tile / tn) * 64, n0 = (tile % tn) * 64;
#pragma unroll
  for (int i = 0; i < 2; ++i) {
    int r = (tid >> 4) + i * 32, c = (tid & 15) * 4;
    float4 v = *(const float4*)(src + (size_t)(k0 + r) * N + n0 + c);
    sm[r * 65 + c] = v.x; sm[r * 65 + c + 1] = v.y; sm[r * 65 + c + 2] = v.z; sm[r * 65 + c + 3] = v.w;
  }
  __syncthreads();
  {
    int n = tid >> 3, kc = (tid & 7) * 8;
    float f[8];
#pragma unroll
    for (int j = 0; j < 8; ++j) f[j] = sm[(kc + j) * 65 + n];
    *(uint4*)(dst + (size_t)(n0 + n) * K + k0 + kc) = pack8(f);
  }
  __syncthreads();
}

__device__ __forceinline__ void ph_convert(int l, unsigned char* smem) {
  const KP p = kparams();
  u16* wb = (u16*)(p->ws + WS_WB);
  float* sm = (float*)smem;
  for (int job = 0; job < 16; ++job) {
    const float* src; int K, N; u16* dst;
    if (job == 0) { src = p->in[I_WIN] + (size_t)l * 1024 * 7040; K = 1024; N = 7040; dst = wb + WO_IN; }
    else if (job < 5) { int g = job - 1; src = p->in[I_POOLW] + ((size_t)l * 4 + g) * 16384; K = 128; N = 128; dst = wb + WO_POOL + g * 16384; }
    else if (job < 7) { int d = job - 5; src = p->in[I_W2] + ((size_t)l * 2 + d) * 64 * 512; K = 64; N = 512; dst = wb + WO_W2 + d * 32768; }
    else if (job < 9) { int d = job - 7; src = p->in[I_A2] + ((size_t)l * 2 + d) * 64 * 512; K = 64; N = 512; dst = wb + WO_A2 + d * 32768; }
    else if (job == 9) { src = p->in[I_G2] + (size_t)l * 128 * 512; K = 128; N = 512; dst = wb + WO_G2; }
    else if (job < 13) { int n = job - 10; src = p->in[I_WBR] + ((size_t)l * 3 + n) * 512 * 1024; K = 512; N = 1024; dst = wb + WO_BR + (size_t)n * 1024 * 512; }
    else if (job == 13) { src = p->in[I_WOUT] + (size_t)l * 1024 * 1024; K = 1024; N = 1024; dst = wb + WO_OUT; }
    else if (job == 14) { src = p->in[I_WUP] + (size_t)l * 1024 * 4096; K = 1024; N = 4096; dst = wb + WO_UP; }
    else { src = p->in[I_WDOWN] + (size_t)l * 4096 * 1024; K = 4096; N = 1024; dst = wb + WO_DOWN; }
    int ntile = (K >> 6) * (N >> 6);
    for (int t = blockIdx.x; t < ntile; t += gridDim.x) conv_tile(src, K, N, dst, t, sm);
  }
}

template <int IN32, int OUT32>
__device__ __forceinline__ void ph_ln(const float* inf, const float* __restrict__ g, const float* __restrict__ b, float* outf, u16* xb) {
  const int tid_ = otid();
  const int wave = tid_ >> 6, lane = tid_ & 63;
#pragma unroll 2
  for (int row = blockIdx.x * 8 + wave; row < NT; row += gridDim.x * 8) {
    float v[16];
    if (IN32) {
      const float4* src = (const float4*)(inf + (size_t)row * DM);
#pragma unroll
      for (int hh = 0; hh < 2; ++hh) {
        float4 a = src[hh * 128 + lane * 2], c = src[hh * 128 + lane * 2 + 1];
        v[hh * 8 + 0] = a.x; v[hh * 8 + 1] = a.y; v[hh * 8 + 2] = a.z; v[hh * 8 + 3] = a.w;
        v[hh * 8 + 4] = c.x; v[hh * 8 + 5] = c.y; v[hh * 8 + 6] = c.z; v[hh * 8 + 7] = c.w;
      }
    } else {
#pragma unroll
      for (int hh = 0; hh < 2; ++hh) { uint4 q = *(const uint4*)(xb + (size_t)row * DM + hh * 512 + lane * 8); unpack8(q, v + hh * 8); }
    }
    float s = 0.f;
#pragma unroll
    for (int i = 0; i < 16; ++i) s += v[i];
#pragma unroll
    for (int m = 1; m < 64; m <<= 1) s = xor_sum(s, m);
    const float mu = s * (1.0f / DM);
    float q2 = 0.f;
#pragma unroll
    for (int i = 0; i < 16; ++i) { const float dd = v[i] - mu; q2 += dd * dd; }
#pragma unroll
    for (int m = 1; m < 64; m <<= 1) q2 = xor_sum(q2, m);
    const float rs = rsqrtf(q2 * (1.0f / DM) + 1e-5f);
#pragma unroll
    for (int hh = 0; hh < 2; ++hh) {
      const int c0 = hh * 512 + lane * 8;
      float o[8];
      const float4 g0 = *(const float4*)(g + c0), g1 = *(const float4*)(g + c0 + 4), b0 = *(const float4*)(b + c0), b1 = *(const float4*)(b + c0 + 4);
      o[0] = (v[hh * 8 + 0] - mu) * rs * g0.x + b0.x; o[1] = (v[hh * 8 + 1] - mu) * rs * g0.y + b0.y;
      o[2] = (v[hh * 8 + 2] - mu) * rs * g0.z + b0.z; o[3] = (v[hh * 8 + 3] - mu) * rs * g0.w + b0.w;
      o[4] = (v[hh * 8 + 4] - mu) * rs * g1.x + b1.x; o[5] = (v[hh * 8 + 5] - mu) * rs * g1.y + b1.y;
      o[6] = (v[hh * 8 + 6] - mu) * rs * g1.z + b1.z; o[7] = (v[hh * 8 + 7] - mu) * rs * g1.w + b1.w;
      if (OUT32) {
        float4* dst = (float4*)(outf + (size_t)row * DM + c0);
        dst[0] = make_float4(o[0], o[1], o[2], o[3]); dst[1] = make_float4(o[4], o[5], o[6], o[7]);
      } else {
        *(uint4*)(xb + (size_t)row * DM + c0) = pack8(o);
      }
    }
  }
}

template <int TM>
__device__ __forceinline__ void gemm_kloop(f32x4 (&acc)[TM][4], const u16* __restrict__ A, int lda, const u16* __restrict__ Bt, int ldb, int K, u16* smem) {
  constexpr int BM = TM * 64;
  u16* sA = smem;
  u16* sB = smem + 2 * BM * LSTR;
  const int tid = otid(), lane = tid & 63, wave = tid >> 6, wm = wave >> 1, wn = wave & 1;
  const int lr = tid >> 3, lc = (tid & 7) * 8;
  uint4 ra0, ra1, ra2 = make_uint4(0, 0, 0, 0), ra3 = make_uint4(0, 0, 0, 0), rb0, rb1;
  const u16* ga = A + (size_t)lr * lda + lc;
  const u16* gb = Bt + (size_t)lr * ldb + lc;
#define GLOAD(k0)                                                                      \
  ra0 = *(const uint4*)(ga + (k0));                                                    \
  ra1 = *(const uint4*)(ga + (size_t)64 * lda + (k0));                                 \
  if (TM > 2) { ra2 = *(const uint4*)(ga + (size_t)128 * lda + (k0)); ra3 = *(const uint4*)(ga + (size_t)192 * lda + (k0)); } \
  rb0 = *(const uint4*)(gb + (k0));                                                    \
  rb1 = *(const uint4*)(gb + (size_t)64 * ldb + (k0));
#define SWRITE(bb)                                                                     \
  *(uint4*)(sA + ((bb) * BM + lr) * LSTR + lc) = ra0;                                  \
  *(uint4*)(sA + ((bb) * BM + lr + 64) * LSTR + lc) = ra1;                             \
  if (TM > 2) { *(uint4*)(sA + ((bb) * BM + lr + 128) * LSTR + lc) = ra2; *(uint4*)(sA + ((bb) * BM + lr + 192) * LSTR + lc) = ra3; } \
  *(uint4*)(sB + ((bb) * 128 + lr) * LSTR + lc) = rb0;                                 \
  *(uint4*)(sB + ((bb) * 128 + lr + 64) * LSTR + lc) = rb1;
  GLOAD(0)
  SWRITE(0)
  __syncthreads();
  int KT = K >> 6;
  asm volatile("" : "+s"(KT));
  for (int kt = 0; kt < KT; ++kt) {
    const int buf = kt & 1;
    if (kt + 1 < KT) {
      const int k0 = (kt + 1) * 64;
      GLOAD(k0)
    }
    const u16* a_base = sA + (buf * BM + wm * TM * 16 + (lane & 15)) * LSTR + (lane >> 4) * 8;
    const u16* b_base = sB + (buf * 128 + wn * 64 + (lane & 15)) * LSTR + (lane >> 4) * 8;
#pragma unroll
    for (int ks = 0; ks < 2; ++ks) {
      bf16x8 af[TM], bfr[4];
#pragma unroll
      for (int tm = 0; tm < TM; ++tm) af[tm] = *(const bf16x8*)(a_base + tm * 16 * LSTR + ks * 32);
#pragma unroll
      for (int tn = 0; tn < 4; ++tn) bfr[tn] = *(const bf16x8*)(b_base + tn * 16 * LSTR + ks * 32);
#pragma unroll
      for (int tm = 0; tm < TM; ++tm)
#pragma unroll
        for (int tn = 0; tn < 4; ++tn) acc[tm][tn] = __builtin_amdgcn_mfma_f32_16x16x32_f16(bfr[tn], af[tm], acc[tm][tn], 0, 0, 0);
    }
    if (kt + 1 < KT) {
      const int nb = buf ^ 1;
      SWRITE(nb)
    }
    __syncthreads();
  }
}

template <int TM>
__device__ __forceinline__ void zero_acc(f32x4 (&acc)[TM][4]) {
#pragma unroll
  for (int tm = 0; tm < TM; ++tm)
#pragma unroll
    for (int tn = 0; tn < 4; ++tn) acc[tm][tn] = f32x4{0.f, 0.f, 0.f, 0.f};
}

__device__ __forceinline__ void gemm_kloop256(f32x4 (&acc)[8][4], const u16* __restrict__ A, int lda, const u16* __restrict__ Bt, int ldb, int K, u16* smem) {
  uint4* sA = (uint4*)smem;
  uint4* sB = sA + 2 * 8 * 256;
  const int tid = otid(), lane = tid & 63, wave = tid >> 6, wm = wave >> 2, wn = wave & 3;
  const int lr = tid >> 3, kcw = tid & 7, lc = kcw * 8;
  uint4 qa0, qa1, qa2, qa3, qb0, qb1, qb2, qb3;
  const int rho_ = lr & 31, bperm_ = (lr & 32) + 8 * ((rho_ & 15) >> 2) + 4 * (rho_ >> 4) + (rho_ & 3);
  const unsigned oa = (unsigned)(lr * lda + lc), ob = (unsigned)(bperm_ * ldb + lc);
  const unsigned sa64 = (unsigned)(64 * lda), sb64 = (unsigned)(64 * ldb);
#define GLOAD2(k0)                                       \
  qa0 = *(const uint4*)(A + (oa + (unsigned)(k0)));                      \
  qa1 = *(const uint4*)(A + (oa + sa64 + (unsigned)(k0)));               \
  qa2 = *(const uint4*)(A + (oa + 2 * sa64 + (unsigned)(k0)));           \
  qa3 = *(const uint4*)(A + (oa + 3 * sa64 + (unsigned)(k0)));           \
  qb0 = *(const uint4*)(Bt + (ob + (unsigned)(k0)));                     \
  qb1 = *(const uint4*)(Bt + (ob + sb64 + (unsigned)(k0)));              \
  qb2 = *(const uint4*)(Bt + (ob + 2 * sb64 + (unsigned)(k0)));          \
  qb3 = *(const uint4*)(Bt + (ob + 3 * sb64 + (unsigned)(k0)));
  const int wofs = kcw * 256 + (lr ^ kcw);
#define SWRITE2(bb)                          \
  sA[(bb) * 2048 + wofs] = qa0;              \
  sA[(bb) * 2048 + wofs + 64] = qa1;         \
  sA[(bb) * 2048 + wofs + 128] = qa2;        \
  sA[(bb) * 2048 + wofs + 192] = qa3;        \
  sB[(bb) * 2048 + wofs] = qb0;              \
  sB[(bb) * 2048 + wofs + 64] = qb1;         \
  sB[(bb) * 2048 + wofs + 128] = qb2;        \
  sB[(bb) * 2048 + wofs + 192] = qb3;
  int KT = K >> 6;
  asm volatile("" : "+s"(KT));
  GLOAD2(0)
  SWRITE2(0)
  if (KT > 1) { GLOAD2(64) }
  __syncthreads();
  const int l15 = lane & 15, g = lane >> 4;
  for (int kt = 0; kt < KT; ++kt) {
    const int buf = kt & 1;
    {
      const uint4* a0p = sA + buf * 2048 + (0 * 4 + g) * 256 + wm * 128 + (l15 ^ (0 * 4 + g));
      const uint4* a1p = sA + buf * 2048 + (1 * 4 + g) * 256 + wm * 128 + (l15 ^ (1 * 4 + g));
      const uint4* b0p = sB + buf * 2048 + (0 * 4 + g) * 256 + wn * 64 + (l15 ^ (0 * 4 + g));
      const uint4* b1p = sB + buf * 2048 + (1 * 4 + g) * 256 + wn * 64 + (l15 ^ (1 * 4 + g));
      bf16x8 bA[4], fA[4], fB[4];
#define LDF4(dst, ptr, o) _Pragma("unroll") for (int i_ = 0; i_ < 4; ++i_) dst[i_] = __builtin_bit_cast(bf16x8, (ptr)[((o) + i_) * 16]);
#define MM16(AF, BF, hf_) { __builtin_amdgcn_s_setprio(1); _Pragma("unroll") for (int tm = 0; tm < 4; ++tm) _Pragma("unroll") for (int tn = 0; tn < 4; ++tn) \
    acc[(hf_) * 4 + tm][tn] = __builtin_amdgcn_mfma_f32_16x16x32_f16(BF[tn], AF[tm], acc[(hf_) * 4 + tm][tn], 0, 0, 0); __builtin_amdgcn_s_setprio(0); }
      LDF4(bA, b0p, 0) LDF4(fA, a0p, 0)
      LDF4(fB, a0p, 4)
      __builtin_amdgcn_sched_barrier(0);
      MM16(fA, bA, 0)
      __builtin_amdgcn_sched_barrier(0);
      LDF4(fA, a1p, 0)
      __builtin_amdgcn_sched_barrier(0);
      MM16(fB, bA, 1)
      __builtin_amdgcn_sched_barrier(0);
      LDF4(bA, b1p, 0) LDF4(fB, a1p, 4)
      __builtin_amdgcn_sched_barrier(0);
      if (kt + 1 < KT) {
        const int nb = buf ^ 1;
        SWRITE2(nb)
        if (kt + 2 < KT) {
          const int k0 = (kt + 2) * 64;
          GLOAD2(k0)
        }
      }
      __builtin_amdgcn_sched_barrier(0);
      MM16(fA, bA, 0)
      __builtin_amdgcn_sched_barrier(0);
      MM16(fB, bA, 1)
    }
    __syncthreads();
  }
}

__device__ __forceinline__ void gemm_kloopS(f32x4 (&acc)[4][4], const u16* __restrict__ A, int lda, const u16* __restrict__ Bt, int ldb, int K, u16* smem) {
  uint4* sA = (uint4*)smem;
  uint4* sB = sA + 2 * 8 * 256;
  const int tid = otid(), lane = tid & 63, wave = tid >> 6, wm = wave >> 1, wn = wave & 1;
  const int lr = tid >> 3, kcw = tid & 7, lc = kcw * 8;
  uint4 qa0, qa1, qa2, qa3, qb0, qb1;
  const int rho_ = lr & 31, bperm_ = (lr & 32) + 8 * ((rho_ & 15) >> 2) + 4 * (rho_ >> 4) + (rho_ & 3);
  const unsigned oa = (unsigned)(lr * lda + lc), ob = (unsigned)(bperm_ * ldb + lc);
  const unsigned sa64 = (unsigned)(64 * lda), sb64 = (unsigned)(64 * ldb);
#define GLOAD3(k0)                                                       \
  qa0 = *(const uint4*)(A + (oa + (unsigned)(k0)));                      \
  qa1 = *(const uint4*)(A + (oa + sa64 + (unsigned)(k0)));               \
  qa2 = *(const uint4*)(A + (oa + 2 * sa64 + (unsigned)(k0)));           \
  qa3 = *(const uint4*)(A + (oa + 3 * sa64 + (unsigned)(k0)));           \
  qb0 = *(const uint4*)(Bt + (ob + (unsigned)(k0)));                     \
  qb1 = *(const uint4*)(Bt + (ob + sb64 + (unsigned)(k0)));
  const int wofa = kcw * 256 + (lr ^ kcw), wofb = kcw * 128 + (lr ^ kcw);
#define SWRITE3(bb)                          \
  sA[(bb) * 2048 + wofa] = qa0;              \
  sA[(bb) * 2048 + wofa + 64] = qa1;         \
  sA[(bb) * 2048 + wofa + 128] = qa2;        \
  sA[(bb) * 2048 + wofa + 192] = qa3;        \
  sB[(bb) * 1024 + wofb] = qb0;              \
  sB[(bb) * 1024 + wofb + 64] = qb1;
  int KT = K >> 6;
  asm volatile("" : "+s"(KT));
  GLOAD3(0)
  SWRITE3(0)
  if (KT > 1) { GLOAD3(64) }
  __syncthreads();
  const int l15 = lane & 15, g = lane >> 4;
  for (int kt = 0; kt < KT; ++kt) {
    const int buf = kt & 1;
    {
      const uint4* a0p = sA + buf * 2048 + (0 * 4 + g) * 256 + wm * 64 + (l15 ^ (0 * 4 + g));
      const uint4* a1p = sA + buf * 2048 + (1 * 4 + g) * 256 + wm * 64 + (l15 ^ (1 * 4 + g));
      const uint4* b0p = sB + buf * 1024 + (0 * 4 + g) * 128 + wn * 64 + (l15 ^ (0 * 4 + g));
      const uint4* b1p = sB + buf * 1024 + (1 * 4 + g) * 128 + wn * 64 + (l15 ^ (1 * 4 + g));
      bf16x8 bA[4], fA[4];
#define MM16S(AF, BF) _Pragma("unroll") for (int tm = 0; tm < 4; ++tm) _Pragma("unroll") for (int tn = 0; tn < 4; ++tn) \
    acc[tm][tn] = __builtin_amdgcn_mfma_f32_16x16x32_f16(BF[tn], AF[tm], acc[tm][tn], 0, 0, 0);
      LDF4(bA, b0p, 0) LDF4(fA, a0p, 0)
      __builtin_amdgcn_sched_barrier(0);
      MM16S(fA, bA)
      __builtin_amdgcn_sched_barrier(0);
      LDF4(bA, b1p, 0) LDF4(fA, a1p, 0)
      __builtin_amdgcn_sched_barrier(0);
      if (kt + 1 < KT) {
        const int nb = buf ^ 1;
        SWRITE3(nb)
        if (kt + 2 < KT) {
          const int k0 = (kt + 2) * 64;
          GLOAD3(k0)
        }
      }
      __builtin_amdgcn_sched_barrier(0);
      MM16S(fA, bA)
    }
    __syncthreads();
  }
}

__device__ __forceinline__ bool tile_sched(int it, int tiles_m, int tiles_n, int& mt, int& nt, bool& valid) {
  const int pnw = tiles_n >= 8 ? 8 : tiles_n;
  const int pmh = 32 / pnw;
  const int pn_cnt = (tiles_n + pnw - 1) / pnw, pm_cnt = tiles_m / pmh;
  const int npatch = pn_cnt * pm_cnt;
  const int g8 = gridDim.x >> 3;
  const int xcd = blockIdx.x & 7, j = blockIdx.x >> 3;
  const int slots_per_round = g8;
  long slot = (long)it * slots_per_round + j;
  int patch_local = (int)(slot >> 5), w = (int)(slot & 31);
  int patch = patch_local * 8 + xcd;
  if (patch >= npatch) return false;
  int pnn = patch % pn_cnt, pmm = patch / pn_cnt;
  mt = pmm * pmh + (w % pmh);
  nt = pnn * pnw + (w / pmh);
  valid = (nt < tiles_n);
  return true;
}

enum { EPI_BF16 = 0, EPI_RES = 1, EPI_RELU2 = 2 };

template <int EPI>
__device__ __forceinline__ void ph_gemm(const u16* A, int lda, const u16* Bt, int ldb, int K, int N, void* Cout, int ldc, u16* smem) {
  const int tid_ = otid();
  const int lane = tid_ & 63, wave = tid_ >> 6, wm = wave >> 1, wn = wave & 1;
  const int tiles_m = NT / 256, tiles_n = N / 128;
  for (int it = 0;; ++it) {
    int mt, nt; bool valid;
    if (!tile_sched(it, tiles_m, tiles_n, mt, nt, valid)) break;
    if (!valid) continue;
    f32x4 acc[4][4];
    zero_acc<4>(acc);
    gemm_kloop<4>(acc, A + (size_t)mt * 256 * lda, lda, Bt + (size_t)nt * 128 * ldb, ldb, K, smem);
#pragma unroll
    for (int tm = 0; tm < 4; ++tm) {
      const int m = mt * 256 + wm * 64 + tm * 16 + (lane & 15);
#pragma unroll
      for (int tn = 0; tn < 4; ++tn) {
        const int n = nt * 128 + wn * 64 + tn * 16 + (lane >> 4) * 4;
        f32x4 a = acc[tm][tn];
        if (EPI == EPI_BF16) {
          *(uint2*)((u16*)Cout + (size_t)m * ldc + n) = make_uint2(pack2(a[0], a[1]), pack2(a[2], a[3]));
        } else if (EPI == EPI_RELU2) {
          float r0 = fmaxf(a[0], 0.f), r1 = fmaxf(a[1], 0.f), r2 = fmaxf(a[2], 0.f), r3 = fmaxf(a[3], 0.f);
          *(uint2*)((u16*)Cout + (size_t)m * ldc + n) = make_uint2(pack2(r0 * r0, r1 * r1), pack2(r2 * r2, r3 * r3));
        } else {
          uint2* px = (uint2*)((u16*)Cout + (size_t)m * ldc + n);
          const uint2 xr = *px;
          const h2_t x01 = __builtin_bit_cast(h2_t, xr.x), x23 = __builtin_bit_cast(h2_t, xr.y);
          const float al = 1.681792830507429f;
          *px = make_uint2(pack2(al * (float)x01[0] + a[0], al * (float)x01[1] + a[1]), pack2(al * (float)x23[0] + a[2], al * (float)x23[1] + a[3]));
        }
      }
    }
  }
}

template <int EPI>
__device__ __forceinline__ void ph_gemm256(const u16* A, int lda, const u16* Bt, int ldb, int K, int N, void* Cout, int ldc, u16* smem) {
  const int tid_ = otid();
  const int lane = tid_ & 63, wave = tid_ >> 6, wm = wave >> 2, wn = wave & 3;
  const int tiles_m = NT / 256, tiles_n = (N + 255) / 256;
  for (int it = 0;; ++it) {
    int mt, nt; bool valid;
    if (!tile_sched(it, tiles_m, tiles_n, mt, nt, valid)) break;
    if (!valid) continue;
    f32x4 acc[8][4];
#pragma unroll
    for (int tm = 0; tm < 8; ++tm)
#pragma unroll
      for (int tn = 0; tn < 4; ++tn) acc[tm][tn] = f32x4{0.f, 0.f, 0.f, 0.f};
    gemm_kloop256(acc, A + (size_t)mt * 256 * lda, lda, Bt + (size_t)nt * 256 * ldb, ldb, K, smem);
#pragma unroll
    for (int tm = 0; tm < 8; ++tm) {
      const int m = mt * 256 + wm * 128 + tm * 16 + (lane & 15);
#pragma unroll
      for (int q2 = 0; q2 < 2; ++q2) {
        const int n = nt * 256 + wn * 64 + q2 * 32 + (lane >> 4) * 8;
        if (n >= N) continue;
        const f32x4 a = acc[tm][2 * q2], c = acc[tm][2 * q2 + 1];
        uint4* px = (uint4*)((u16*)Cout + (size_t)m * ldc + n);
        if (EPI == EPI_BF16) {
          *px = make_uint4(pack2(a[0], a[1]), pack2(a[2], a[3]), pack2(c[0], c[1]), pack2(c[2], c[3]));
        } else if (EPI == EPI_RELU2) {
          const float r0 = fmaxf(a[0], 0.f), r1 = fmaxf(a[1], 0.f), r2 = fmaxf(a[2], 0.f), r3 = fmaxf(a[3], 0.f);
          const float r4 = fmaxf(c[0], 0.f), r5 = fmaxf(c[1], 0.f), r6 = fmaxf(c[2], 0.f), r7 = fmaxf(c[3], 0.f);
          *px = make_uint4(pack2(r0 * r0, r1 * r1), pack2(r2 * r2, r3 * r3), pack2(r4 * r4, r5 * r5), pack2(r6 * r6, r7 * r7));
        } else {
          const uint4 xr = *px;
          float xf[8];
          unpack8(xr, xf);
          const float al = 1.681792830507429f;
          *px = make_uint4(pack2(al * xf[0] + a[0], al * xf[1] + a[1]), pack2(al * xf[2] + a[2], al * xf[3] + a[3]),
                           pack2(al * xf[4] + c[0], al * xf[5] + c[1]), pack2(al * xf[6] + c[2], al * xf[7] + c[3]));
        }
      }
    }
  }
}

__device__ __forceinline__ void ph_prep_gemm(int l, u16* smem) {
  const KP p = kparams();
  const int tid_ = otid();
  const int lane = tid_ & 63, wave = tid_ >> 6, wm = wave >> 1, wn = wave & 1;
  u16* P = (u16*)(p->ws + WS_P);
  const u16* wb = (const u16*)(p->ws + WS_WB);
  u16* prepE = (u16*)(p->ws + WS_PREP);
  u16* prepA = prepE + (size_t)2 * NT * 512;
  u16* gate = (u16*)(p->ws + WS_GATE);
  const int total = 512 + 5 * 512;
  for (int t = blockIdx.x; t < total; t += gridDim.x) {
    int job, mt, nt;
    if (t < 512) { job = t & 3; mt = t >> 2; nt = 0; }
    else { int t2 = t - 512; job = 4 + (t2 >> 9); int r = t2 & 511; nt = r & 3; mt = r >> 2; }
    const u16 *A, *Bt; int K, ldb;
    if (job < 4) { A = P + PC_K + job * 128; Bt = wb + WO_POOL + job * 16384; K = 128; ldb = 128; }
    else if (job < 6) { int d = job - 4; A = P + PC_V + d * 64; Bt = wb + WO_W2 + d * 32768; K = 64; ldb = 64; }
    else if (job < 8) { int d = job - 6; A = P + PC_V + 128 + d * 64; Bt = wb + WO_A2 + d * 32768; K = 64; ldb = 64; }
    else { A = P + PC_V + 256; Bt = wb + WO_G2; K = 128; ldb = 128; }
    f32x4 acc[4][4];
    zero_acc<4>(acc);
    gemm_kloopS(acc, A + (size_t)mt * 256 * LDP, LDP, Bt + (size_t)nt * 128 * ldb, ldb, K, smem);
#pragma unroll
    for (int tm = 0; tm < 4; ++tm) {
      const int m = mt * 256 + wm * 64 + tm * 16 + (lane & 15);
#pragma unroll
      for (int q2 = 0; q2 < 2; ++q2) {
        const int n = nt * 128 + wn * 64 + q2 * 32 + (lane >> 4) * 8;
        const f32x4 a = acc[tm][2 * q2], c = acc[tm][2 * q2 + 1];
        float v8[8] = {a[0], a[1], a[2], a[3], c[0], c[1], c[2], c[3]};
        if (job < 4) {
          const float4 s0 = *(const float4*)(p->in[I_POOLS] + (size_t)l * 512 + job * 128 + n), s1 = *(const float4*)(p->in[I_POOLS] + (size_t)l * 512 + job * 128 + n + 4);
          v8[0] *= s0.x; v8[1] *= s0.y; v8[2] *= s0.z; v8[3] *= s0.w; v8[4] *= s1.x; v8[5] *= s1.y; v8[6] *= s1.z; v8[7] *= s1.w;
          *(uint4*)(P + (size_t)m * LDP + PC_K + job * 128 + n) = pack8(v8);
        } else if (job < 6) {
          const int d = job - 4;
          const float* w0p = p->in[I_W0] + ((size_t)l * 2 + d) * 512 + n;
          const float4 s0 = *(const float4*)w0p, s1 = *(const float4*)(w0p + 4);
          const float cc = 0.6065306597126334f;
          v8[0] = cc * sigmoidf_(s0.x + v8[0]); v8[1] = cc * sigmoidf_(s0.y + v8[1]); v8[2] = cc * sigmoidf_(s0.z + v8[2]); v8[3] = cc * sigmoidf_(s0.w + v8[3]);
          v8[4] = cc * sigmoidf_(s1.x + v8[4]); v8[5] = cc * sigmoidf_(s1.y + v8[5]); v8[6] = cc * sigmoidf_(s1.z + v8[6]); v8[7] = cc * sigmoidf_(s1.w + v8[7]);
          *(uint4*)(prepE + ((size_t)d * NT + m) * 512 + n) = pack8(v8);
        } else if (job < 8) {
          const int d = job - 6;
          const float* a0p = p->in[I_A0] + ((size_t)l * 2 + d) * 512 + n;
          const float4 s0 = *(const float4*)a0p, s1 = *(const float4*)(a0p + 4);
          v8[0] = sigmoidf_(s0.x + v8[0]); v8[1] = sigmoidf_(s0.y + v8[1]); v8[2] = sigmoidf_(s0.z + v8[2]); v8[3] = sigmoidf_(s0.w + v8[3]);
          v8[4] = sigmoidf_(s1.x + v8[4]); v8[5] = sigmoidf_(s1.y + v8[5]); v8[6] = sigmoidf_(s1.z + v8[6]); v8[7] = sigmoidf_(s1.w + v8[7]);
          *(uint4*)(prepA + ((size_t)d * NT + m) * 512 + n) = pack8(v8);
        } else {
          *(uint4*)(gate + (size_t)m * 512 + n) = pack8(v8);
        }
      }
    }
  }
}

__device__ __forceinline__ void ph_merge(int l, u16* smem) {
  const KP p = kparams();
  const int tid_ = otid();
  const int lane = tid_ & 63, wave = tid_ >> 6, wm = wave >> 1, wn = wave & 1;
  const u16* P = (const u16*)(p->ws + WS_P);
  const u16* xn = (const u16*)(p->ws + WS_XN);
  const u16* wb = (const u16*)(p->ws + WS_WB);
  u16* merged = (u16*)(p->ws + WS_PREP);
  const float* bg = p->in[I_BG] + (size_t)l * 3 * 1024;
  const int tiles_m = NT / 256, tiles_n = 8;
  for (int it = 0;; ++it) {
    int mt, nt; bool valid;
    if (!tile_sched(it, tiles_m, tiles_n, mt, nt, valid)) break;
    if (!valid) continue;
    int NB3 = 3;
    asm volatile("" : "+s"(NB3));
    for (int nb = 0; nb < NB3; ++nb) {
      uint2 gt[4][4];
      {
        f32x4 accG[4][4];
        zero_acc<4>(accG);
        gemm_kloopS(accG, xn + (size_t)mt * 256 * 1024, 1024, wb + WO_IN + (size_t)(3968 + nb * 1024 + nt * 128) * 1024, 1024, 1024, smem);
#pragma unroll
        for (int tn = 0; tn < 4; ++tn) {
          const int n = nt * 128 + wn * 64 + (tn >> 1) * 32 + (lane >> 4) * 8 + (tn & 1) * 4;
          const float4 b4 = *(const float4*)(bg + nb * 1024 + n);
#pragma unroll
          for (int tm = 0; tm < 4; ++tm)
            gt[tm][tn] = make_uint2(pack2(sigmoidf_(accG[tm][tn][0] + b4.x), sigmoidf_(accG[tm][tn][1] + b4.y)),
                                    pack2(sigmoidf_(accG[tm][tn][2] + b4.z), sigmoidf_(accG[tm][tn][3] + b4.w)));
        }
      }
      f32x4 accB[4][4];
      zero_acc<4>(accB);
      const int col = (nb == 0) ? PC_K : (nb == 1 ? PC_Q : PC_U);
      gemm_kloopS(accB, P + (size_t)mt * 256 * LDP + col, LDP, wb + WO_BR + (size_t)(nb * 1024 + nt * 128) * 512, 512, 512, smem);
      unsigned obase = (unsigned)((mt * 256 + wm * 64 + (lane & 15)) * 1024 + nt * 128 + wn * 64 + (lane >> 4) * 8);
      asm volatile("" : "+v"(obase));
#pragma unroll
      for (int tm = 0; tm < 4; ++tm) {
#pragma unroll
        for (int q2 = 0; q2 < 2; ++q2) {
          uint4* dst = (uint4*)(merged + (obase + (unsigned)(tm * 16 * 1024 + q2 * 32)));
          float mf[8] = {0.f, 0.f, 0.f, 0.f, 0.f, 0.f, 0.f, 0.f};
          if (nb > 0) { const uint4 prev = *dst; unpack8(prev, mf); }
          const h2_t g01 = __builtin_bit_cast(h2_t, gt[tm][2 * q2].x), g23 = __builtin_bit_cast(h2_t, gt[tm][2 * q2].y);
          const h2_t g45 = __builtin_bit_cast(h2_t, gt[tm][2 * q2 + 1].x), g67 = __builtin_bit_cast(h2_t, gt[tm][2 * q2 + 1].y);
          const f32x4 ba = accB[tm][2 * q2], bc = accB[tm][2 * q2 + 1];
          *dst = make_uint4(pack2(mf[0] + (float)g01[0] * ba[0], mf[1] + (float)g01[1] * ba[1]), pack2(mf[2] + (float)g23[0] * ba[2], mf[3] + (float)g23[1] * ba[3]),
                            pack2(mf[4] + (float)g45[0] * bc[0], mf[5] + (float)g45[1] * bc[1]), pack2(mf[6] + (float)g67[0] * bc[2], mf[7] + (float)g67[1] * bc[3]));
        }
      }
    }
  }
}

__device__ __forceinline__ int rel_bucket_dev(int rel) {
  int n = rel < 0 ? -rel : rel;
  int b;
  if (n < 8) b = n; else if (n < 12) b = 8; else if (n < 16) b = 9; else if (n < 23) b = 10; else if (n < 32) b = 11;
  else if (n < 46) b = 12; else if (n < 64) b = 13; else if (n < 91) b = 14; else b = 15;
  return b + (rel > 0 ? 16 : 0);
}

__device__ __forceinline__ void ph_attn(int l, unsigned char* smem_raw, bool dummy_out) {
  const KP p = kparams();
  constexpr int KSTR = 136, VSTR = 72;
  u16* sK = (u16*)smem_raw;
  u16* sVt = sK + 2 * 64 * KSTR;
  float* lut = (float*)(sVt + 2 * 128 * VSTR);
  u16* P = (u16*)(p->ws + WS_P);
  const int tid = otid(), lane = tid & 63, wave = tid >> 6, g = lane >> 4, l15 = lane & 15;
  const float LOG2E = 1.4426950408889634f;
  const float* lf = p->in[I_LAM] + (size_t)l * 256;
  float s01 = lf[lane] * lf[64 + lane], s23 = lf[128 + lane] * lf[192 + lane];
#pragma unroll
  for (int m = 1; m < 64; m <<= 1) { s01 = xor_sum(s01, m); s23 = xor_sum(s23, m); }
  const float lam_init = 0.8f - 0.6f * __expf(-0.3f * (float)l);
  const float lam = __expf(s01) - __expf(s23) + lam_init;
  const float* relb = p->in[I_REL];
  const float* subg = p->in[I_SUBG] + (size_t)l * 128;
  const int g8 = gridDim.x >> 3, xcd = blockIdx.x & 7, jb = blockIdx.x >> 3;
  for (int it = 0;; ++it) {
    const int unit = (it * 8 + xcd) * g8 + jb;
    if (it * 8 * g8 >= 1024) break;
    if (unit >= 1024) continue;
    const int b = unit >> 6, h = (unit >> 4) & 3, qb = unit & 15;
    const size_t tok0 = (size_t)b * SEQ;
    __syncthreads();
    if (tid < 257) lut[tid] = relb[rel_bucket_dev(tid - 128) * 4 + h] * LOG2E;
    const float bias_far_neg = relb[15 * 4 + h] * LOG2E, bias_far_pos = relb[31 * 4 + h] * LOG2E;
    const int qpos = qb * 128 + wave * 16 + l15;
    bf16x8 qf[2][2];
    {
      const u16* qp = P + (tok0 + qpos) * LDP + PC_Q + h * 128 + g * 8;
#pragma unroll
      for (int mp = 0; mp < 2; ++mp)
#pragma unroll
        for (int ks = 0; ks < 2; ++ks) qf[mp][ks] = *(const bf16x8*)(qp + mp * 64 + ks * 32);
    }
    f32x4 O[2][8];
#pragma unroll
    for (int mp = 0; mp < 2; ++mp)
#pragma unroll
      for (int d = 0; d < 8; ++d) O[mp][d] = f32x4{0.f, 0.f, 0.f, 0.f};
    float mrow[2] = {-1e30f, -1e30f}, lrow[2] = {0.f, 0.f};
    const u16* kg = P + (tok0 + (tid >> 4)) * LDP + PC_K + h * 128 + (tid & 15) * 8;
    const u16* vg = P + (tok0 + lane) * LDP + PC_V + h * 128 + wave * 16;
    uint4 rk0, rk1, rv0, rv1;
    rk0 = *(const uint4*)(kg); rk1 = *(const uint4*)(kg + (size_t)32 * LDP); rv0 = *(const uint4*)(vg); rv1 = *(const uint4*)(vg + 8);
#define VST(vd, rv)                                                                   \
  vd[0 * VSTR] = (u16)(rv.x & 0xffff); vd[1 * VSTR] = (u16)(rv.x >> 16);              \
  vd[2 * VSTR] = (u16)(rv.y & 0xffff); vd[3 * VSTR] = (u16)(rv.y >> 16);              \
  vd[4 * VSTR] = (u16)(rv.z & 0xffff); vd[5 * VSTR] = (u16)(rv.z >> 16);              \
  vd[6 * VSTR] = (u16)(rv.w & 0xffff); vd[7 * VSTR] = (u16)(rv.w >> 16);
#define STAGE(bb)                                                                     \
  {                                                                                   \
    ((uint4*)sK)[(bb) * 1024 + (tid & 15) * 64 + ((tid >> 4) ^ (tid & 7))] = rk0;          \
    ((uint4*)sK)[(bb) * 1024 + (tid & 15) * 64 + ((tid >> 4) ^ (tid & 7)) + 32] = rk1;     \
    u16* vd0 = sVt + ((bb) * 128 + wave * 16) * VSTR + lane;                          \
    u16* vd1 = vd0 + 8 * VSTR;                                                        \
    VST(vd0, rv0) VST(vd1, rv1)                                                       \
  }
    STAGE(0)
    rk0 = *(const uint4*)(kg + ((size_t)64) * LDP);
    rk1 = *(const uint4*)(kg + ((size_t)64 + 32) * LDP);
    rv0 = *(const uint4*)(vg + (size_t)64 * LDP);
    rv1 = *(const uint4*)(vg + (size_t)64 * LDP + 8);
    __syncthreads();
    int NKT = 32;
    asm volatile("" : "+s"(NKT));
    for (int kt = 0; kt < NKT; ++kt) {
      const int buf = kt & 1;
      const int kmin = kt * 64, qmin = qb * 128 + wave * 16;
      const float qs = 0.125f * LOG2E;
      const bool far = (kmin - (qmin + 15) >= 91) || (qmin - (kmin + 63) >= 91);
      const float bfar = (kmin > qmin) ? bias_far_pos : bias_far_neg;
      bf16x8 pf[2][2];
#pragma unroll
      for (int mp = 0; mp < 2; ++mp) {
        f32x4 sc[4];
#pragma unroll
        for (int kk = 0; kk < 4; ++kk) {
          f32x4 a = {0.f, 0.f, 0.f, 0.f};
#pragma unroll
          for (int ks = 0; ks < 2; ++ks) {
            bf16x8 kf = __builtin_bit_cast(bf16x8, ((const uint4*)sK)[buf * 1024 + (mp * 8 + ks * 4 + g) * 64 + kk * 16 + (l15 ^ (ks * 4 + g))]);
            a = __builtin_amdgcn_mfma_f32_16x16x32_f16(kf, qf[mp][ks], a, 0, 0, 0);
          }
          sc[kk] = a;
        }
        if (far) {
#pragma unroll
          for (int kk = 0; kk < 4; ++kk)
#pragma unroll
            for (int j = 0; j < 4; ++j) sc[kk][j] = sc[kk][j] * qs + bfar;
        } else {
#pragma unroll
          for (int kk = 0; kk < 4; ++kk)
#pragma unroll
            for (int j = 0; j < 4; ++j) {
              int rel = kmin + kk * 16 + g * 4 + j - qpos;
              rel = rel < -128 ? -128 : (rel > 128 ? 128 : rel);
              sc[kk][j] = sc[kk][j] * qs + lut[rel + 128];
            }
        }
        float mx = sc[0][0];
#pragma unroll
        for (int kk = 0; kk < 4; ++kk)
#pragma unroll
          for (int j = 0; j < 4; ++j) mx = fmaxf(mx, sc[kk][j]);
        mx = fmaxf(mx, __shfl_xor(mx, 16));
        mx = fmaxf(mx, __shfl_xor(mx, 32));
        const float mnew = fmaxf(mrow[mp], mx);
        const float alpha = __builtin_amdgcn_exp2f(mrow[mp] - mnew);
        mrow[mp] = mnew;
        float ps = 0.f;
#pragma unroll
        for (int kk = 0; kk < 4; ++kk)
#pragma unroll
          for (int j = 0; j < 4; ++j) { float ev = __builtin_amdgcn_exp2f(sc[kk][j] - mnew); sc[kk][j] = ev; ps += ev; }
        lrow[mp] = lrow[mp] * alpha + ps;
#pragma unroll
        for (int d = 0; d < 8; ++d) { O[mp][d][0] *= alpha; O[mp][d][1] *= alpha; O[mp][d][2] *= alpha; O[mp][d][3] *= alpha; }
#pragma unroll
        for (int kb = 0; kb < 2; ++kb) {
          uint4 u = make_uint4(pack2(sc[2 * kb][0], sc[2 * kb][1]), pack2(sc[2 * kb][2], sc[2 * kb][3]),
                               pack2(sc[2 * kb + 1][0], sc[2 * kb + 1][1]), pack2(sc[2 * kb + 1][2], sc[2 * kb + 1][3]));
          pf[mp][kb] = __builtin_bit_cast(bf16x8, u);
        }
        __builtin_amdgcn_sched_barrier(0);
      }
      if (kt + 1 < NKT) {
        STAGE(buf ^ 1)
        if (kt + 2 < NKT) {
          rk0 = *(const uint4*)(kg + ((size_t)(kt + 2) * 64) * LDP);
          rk1 = *(const uint4*)(kg + ((size_t)(kt + 2) * 64 + 32) * LDP);
          rv0 = *(const uint4*)(vg + (size_t)(kt + 2) * 64 * LDP);
          rv1 = *(const uint4*)(vg + (size_t)(kt + 2) * 64 * LDP + 8);
        }
      }
      __builtin_amdgcn_sched_barrier(0);
#pragma unroll
      for (int kb = 0; kb < 2; ++kb)
#pragma unroll
        for (int d = 0; d < 8; ++d) {
          const u16* vp = sVt + (buf * 128 + d * 16 + l15) * VSTR + kb * 32 + g * 4;
          uint2 lo = *(const uint2*)vp, hi = *(const uint2*)(vp + 16);
          bf16x8 vf = __builtin_bit_cast(bf16x8, make_uint4(lo.x, lo.y, hi.x, hi.y));
          O[0][d] = __builtin_amdgcn_mfma_f32_16x16x32_f16(vf, pf[0][kb], O[0][d], 0, 0, 0);
          O[1][d] = __builtin_amdgcn_mfma_f32_16x16x32_f16(vf, pf[1][kb], O[1][d], 0, 0, 0);
          if (d & 1) __builtin_amdgcn_sched_barrier(0);
        }
      __syncthreads();
    }
    float l0 = lrow[0], l1 = lrow[1];
    l0 = xor_sum(l0, 16); l0 = xor_sum(l0, 32);
    l1 = xor_sum(l1, 16); l1 = xor_sum(l1, 32);
    const float i0 = 1.0f / l0, i1 = lam / l1;
    float ss = 0.f;
#pragma unroll
    for (int d = 0; d < 8; ++d)
#pragma unroll
      for (int j = 0; j < 4; ++j) { float o = O[0][d][j] * i0 - O[1][d][j] * i1; O[0][d][j] = o; ss += o * o; }
    ss = xor_sum(ss, 16); ss = xor_sum(ss, 32);
    const float scl = rsqrtf(ss * (1.0f / 128.0f) + 1e-5f) * (1.0f - lam_init);
    u16* op = dummy_out ? ((u16*)(p->ws + WS_GATE) + (tok0 + qpos) * 512 + h * 128 + g * 4) : (P + (tok0 + qpos) * LDP + PC_Q + h * 128 + g * 4);
#pragma unroll
    for (int d = 0; d < 8; ++d) {
      float4 gg = *(const float4*)(subg + d * 16 + g * 4);
      *(uint2*)(op + d * 16) = make_uint2(pack2(O[0][d][0] * scl * gg.x, O[0][d][1] * scl * gg.y), pack2(O[0][d][2] * scl * gg.z, O[0][d][3] * scl * gg.w));
    }
  }
}

__device__ __forceinline__ void ph_poolmix_lr(int l) {
  const KP p = kparams();
  u16* P = (u16*)(p->ws + WS_P);
  const int tid_ = otid();
  const int wave = tid_ >> 6, lane = tid_ & 63;
  const float* mup = p->in[I_MUP] + (size_t)l * 1920 + 1536;
  const float* mun = p->in[I_MUN] + (size_t)l * 1920 + 1536;
  const int c0 = lane * 8, gi = lane >> 4;
  const int win = 2 << gi, left = win >> 1, right = win - 1 - left;
  float mneg[9], mpos[8];
#pragma unroll
  for (int k = 1; k <= 8; ++k) mneg[k] = (left >= k) ? 1.f : 0.f;
#pragma unroll
  for (int k = 1; k <= 7; ++k) mpos[k] = (right >= k) ? 1.f : 0.f;
  int NRUN = NT / 4;
  asm volatile("" : "+s"(NRUN));
  for (int run = blockIdx.x * 8 + wave; run < NRUN; run += gridDim.x * 8) {
    const int t0 = run * 4, s0 = t0 & (SEQ - 1);
    {
      float acc[4][8];
#pragma unroll
      for (int i = 0; i < 4; ++i)
#pragma unroll
        for (int e = 0; e < 8; ++e) acc[i][e] = 0.f;
      float cm[4], icnt[4];
#pragma unroll
      for (int i = 0; i < 4; ++i) {
        const int s = s0 + i;
        const float cnt = (float)(min(s + right + 1, SEQ) - max(s - left, 0));
        cm[i] = 1.0f - cnt;
        icnt[i] = __builtin_amdgcn_rcpf(cnt);
      }
#pragma unroll
      for (int q = 0; q < 19; ++q) {
        const int rr = s0 - 8 + q;
        uint4 raw = make_uint4(0, 0, 0, 0);
        if (rr >= 0 && rr < SEQ) raw = *(const uint4*)(P + (size_t)(t0 - 8 + q) * LDP + PC_U + c0);
        float f[8];
        unpack8(raw, f);
#pragma unroll
        for (int i = 0; i < 4; ++i) {
          const int dl = q - 8 - i;
          if (dl < -8 || dl > 7) continue;
          const float m = (dl < 0) ? mneg[dl < 0 ? -dl : 1] : (dl > 0 ? mpos[dl > 0 ? dl : 1] : cm[i]);
#pragma unroll
          for (int e = 0; e < 8; ++e) acc[i][e] += m * f[e];
        }
        if (q % 6 == 5) __builtin_amdgcn_sched_barrier(0);
      }
#pragma unroll
      for (int i = 0; i < 4; ++i) {
#pragma unroll
        for (int e = 0; e < 8; ++e) acc[i][e] *= icnt[i];
        *(uint4*)(P + (size_t)(t0 + i) * LDP + PC_K + c0) = pack8(acc[i]);
      }
    }
    if (lane < 48) {
      uint4 raw[6];
#pragma unroll
      for (int q = 0; q < 6; ++q) {
        const int rr = s0 - 1 + q;
        raw[q] = make_uint4(0, 0, 0, 0);
        if (rr >= 0 && rr < SEQ) raw[q] = *(const uint4*)(P + (size_t)(t0 - 1 + q) * LDP + PC_LW + c0);
      }
      float mp[8], mn[8];
#pragma unroll
      for (int e = 0; e < 8; ++e) { mp[e] = mup[c0 + e]; mn[e] = mun[c0 + e]; }
#pragma unroll
      for (int i = 0; i < 4; ++i) {
        float z[8], zp[8], zn[8], o[8];
        unpack8(raw[i], zp); unpack8(raw[i + 1], z); unpack8(raw[i + 2], zn);
#pragma unroll
        for (int e = 0; e < 8; ++e) {
          float v = z[e] + mp[e] * (zp[e] - z[e]) + mn[e] * (zn[e] - z[e]);
          if (c0 < 128) v = tanh_fast(v);
          else if (c0 >= 256) v = sigmoidf_(v);
          o[e] = v;
        }
        *(uint4*)(P + (size_t)(t0 + i) * LDP + PC_V + c0) = pack8(o);
      }
    }
  }
}

#define DPP_ROW(m) " row_newbcast:" #m " row_mask:0xf bank_mask:0xf\n"
__device__ __forceinline__ float scan_dot(const float (&S)[16], float x) {
  float r0, r1, r2, r3;
  asm volatile("s_nop 4\n"
               "v_mul_f32_dpp %0, %20, %4" DPP_ROW(0) "v_mul_f32_dpp %1, %20, %5" DPP_ROW(1) "v_mul_f32_dpp %2, %20, %6" DPP_ROW(2) "v_mul_f32_dpp %3, %20, %7" DPP_ROW(3)
               "v_fmac_f32_dpp %0, %20, %8" DPP_ROW(4) "v_fmac_f32_dpp %1, %20, %9" DPP_ROW(5) "v_fmac_f32_dpp %2, %20, %10" DPP_ROW(6) "v_fmac_f32_dpp %3, %20, %11" DPP_ROW(7)
               "v_fmac_f32_dpp %0, %20, %12" DPP_ROW(8) "v_fmac_f32_dpp %1, %20, %13" DPP_ROW(9) "v_fmac_f32_dpp %2, %20, %14" DPP_ROW(10) "v_fmac_f32_dpp %3, %20, %15" DPP_ROW(11)
               "v_fmac_f32_dpp %0, %20, %16" DPP_ROW(12) "v_fmac_f32_dpp %1, %20, %17" DPP_ROW(13) "v_fmac_f32_dpp %2, %20, %18" DPP_ROW(14) "v_fmac_f32_dpp %3, %20, %19" DPP_ROW(15)
               : "=&v"(r0), "=&v"(r1), "=&v"(r2), "=&v"(r3)
               : "v"(S[0]), "v"(S[1]), "v"(S[2]), "v"(S[3]), "v"(S[4]), "v"(S[5]), "v"(S[6]), "v"(S[7]), "v"(S[8]), "v"(S[9]), "v"(S[10]), "v"(S[11]),
                 "v"(S[12]), "v"(S[13]), "v"(S[14]), "v"(S[15]), "v"(x));
  return (r0 + r1) + (r2 + r3);
}
#define UPD_B(i) "v_fmac_f32_dpp %" #i ", %16, %18" DPP_ROW(i)
#define UPD_K(i) "v_fmac_f32_dpp %" #i ", %17, %19" DPP_ROW(i)
#define ALL16(M) M(0) M(1) M(2) M(3) M(4) M(5) M(6) M(7) M(8) M(9) M(10) M(11) M(12) M(13) M(14) M(15)
__device__ __forceinline__ void scan_rank2(fl2_t (&S2)[8], float b, float kd, float sa, float v) {
  asm volatile("s_nop 4\n" ALL16(UPD_B) ALL16(UPD_K)
               : "+v"(S2[0][0]), "+v"(S2[0][1]), "+v"(S2[1][0]), "+v"(S2[1][1]), "+v"(S2[2][0]), "+v"(S2[2][1]), "+v"(S2[3][0]), "+v"(S2[3][1]),
                 "+v"(S2[4][0]), "+v"(S2[4][1]), "+v"(S2[5][0]), "+v"(S2[5][1]), "+v"(S2[6][0]), "+v"(S2[6][1]), "+v"(S2[7][0]), "+v"(S2[7][1])
               : "v"(b), "v"(kd), "v"(sa), "v"(v));
}
__device__ __forceinline__ float rows_allreduce(float x) {
  f32x4 z = {0.f, 0.f, 0.f, 0.f};
  f32x4 r = __builtin_amdgcn_mfma_f32_16x16x4f32(1.0f, x, z, 0, 0, 0);
  return r[0];
}

typedef __attribute__((ext_vector_type(8))) short s16x8;
__device__ __forceinline__ unsigned pack2bf(float a, float b) { fl2_t v = {a, b}; bf2_t h = __builtin_convertvector(v, bf2_t); return __builtin_bit_cast(unsigned, h); }
__device__ __forceinline__ s16x8 mk8(uint2 lo, uint2 hi) { return __builtin_bit_cast(s16x8, make_uint4(lo.x, lo.y, hi.x, hi.y)); }
__device__ __forceinline__ uint2 cvt4bf(f32x4 a) { return make_uint2(pack2bf(a[0], a[1]), pack2bf(a[2], a[3])); }
__device__ __forceinline__ f32x4 mmbf(s16x8 a, s16x8 b, f32x4 c) { return __builtin_amdgcn_mfma_f32_16x16x32_bf16(a, b, c, 0, 0, 0); }
__device__ __forceinline__ f32x4 mm16(f32x4 PT, f32x4 Q) {
  const uint2 z = make_uint2(0, 0);
  return mmbf(mk8(cvt4bf(PT), z), mk8(cvt4bf(Q), z), f32x4{0.f, 0.f, 0.f, 0.f});
}
constexpr int CB_KKT = 0, CB_RT = 2304, CB_WT = 4608, CB_VBT = 9728, CB_CC = 12800, CB_AN1 = 13056, CB_AT = 13824, CB_AY = 14592, CB_SIZE = 16384;
constexpr int CB_BH = CB_WT, CB_KH = CB_WT + 2304;

__device__ __forceinline__ void ph_scan(int l, unsigned char* smem_raw) {
  const KP p = kparams();
  u16* P = (u16*)(p->ws + WS_P);
  const u16* prepE = (const u16*)(p->ws + WS_PREP);
  const u16* prepA = prepE + (size_t)2 * NT * 512;
  const int tid = otid(), wave = tid >> 6, lane = tid & 63, l15 = lane & 15, g = lane >> 4;
  const uint2 z2 = make_uint2(0, 0);
  for (int chain = blockIdx.x; chain < 256; chain += gridDim.x) {
    const int b = chain >> 4, h = (chain >> 1) & 7, d = chain & 1;
    const size_t tok0 = (size_t)b * SEQ;
    const int ycol = (d == 0 ? PC_U : PC_V) + h * 64;
    f32x4 ST[4];
#pragma unroll
    for (int jt = 0; jt < 4; ++jt) ST[jt] = f32x4{0.f, 0.f, 0.f, 0.f};
    __syncthreads();
    int NG = SEQ / 64;
    asm volatile("" : "+s"(NG));
#define HLD3(dst, o_, which_, chn_, tp_, row_)                                                                                  \
  dst[(o_) + 0] = *(const uint4*)((row_) + PC_R + (which_) * 512 + (chn_));                                                      \
  dst[(o_) + 1] = ((tp_) > 0) ? *(const uint4*)((row_) - LDP + PC_R + (which_) * 512 + (chn_)) : make_uint4(0, 0, 0, 0);         \
  dst[(o_) + 2] = ((tp_) < SEQ - 1) ? *(const uint4*)((row_) + LDP + PC_R + (which_) * 512 + (chn_)) : make_uint4(0, 0, 0, 0);
    for (int gi = 0; gi <= NG; ++gi) {
      if (wave < 4) {
        if (gi >= 1) {
          int NC4 = 4;
          asm volatile("" : "+s"(NC4));
          for (int cc = 0; cc < NC4; ++cc) {
            const unsigned char* cb = smem_raw + (((gi - 1) & 1) * 4 + cc) * CB_SIZE;
            const u16* kkt = (const u16*)(cb + CB_KKT) + l15 * 72 + g * 4;
            const u16* rt = (const u16*)(cb + CB_RT) + l15 * 72 + g * 4;
            const u16* vbt = (const u16*)(cb + CB_VBT) + (wave * 16 + l15) * 24 + g * 4;
            const s16x8 sb0 = mk8(cvt4bf(ST[0]), cvt4bf(ST[1])), sb1 = mk8(cvt4bf(ST[2]), cvt4bf(ST[3]));
            const uint2 vq = *(const uint2*)vbt;
            f32x4 UT = mmbf(mk8(*(const uint2*)(kkt), *(const uint2*)(kkt + 16)), sb0, f32x4{0.f, 0.f, 0.f, 0.f});
            UT = mmbf(mk8(*(const uint2*)(kkt + 32), *(const uint2*)(kkt + 48)), sb1, UT);
            UT = mmbf(mk8(*(const uint2*)((const u16*)(cb + CB_AN1) + l15 * 24 + g * 4), z2), mk8(vq, z2), UT);
            f32x4 SAT = mmbf(mk8(*(const uint2*)((const u16*)(cb + CB_AT) + l15 * 24 + g * 4), z2), mk8(cvt4bf(UT), z2), f32x4{0.f, 0.f, 0.f, 0.f});
            const s16x8 bsv = mk8(cvt4bf(SAT), vq);
            f32x4 YT = mmbf(mk8(*(const uint2*)(rt), *(const uint2*)(rt + 16)), sb0, f32x4{0.f, 0.f, 0.f, 0.f});
            YT = mmbf(mk8(*(const uint2*)(rt + 32), *(const uint2*)(rt + 48)), sb1, YT);
            YT = mmbf(*(const s16x8*)((const u16*)(cb + CB_AY) + l15 * 40 + g * 8), bsv, YT);
#pragma unroll
            for (int jt = 0; jt < 4; ++jt) {
              const float4 c4 = *(const float4*)((const float*)(cb + CB_CC) + jt * 16 + g * 4);
              f32x4 sc = ST[jt];
              sc[0] *= c4.x; sc[1] *= c4.y; sc[2] *= c4.z; sc[3] *= c4.w;
              ST[jt] = mmbf(*(const s16x8*)((const u16*)(cb + CB_WT) + (jt * 16 + l15) * 40 + g * 8), bsv, sc);
            }
            const int step0 = ((gi - 1) * 4 + cc) * 16 + g * 4;
#pragma unroll
            for (int r = 0; r < 4; ++r) {
              const int step = step0 + r;
              const int tp = d ? (SEQ - 1 - step) : step;
              P[(tok0 + tp) * LDP + ycol + wave * 16 + l15] = (u16)(pack2(YT[r], 0.f) & 0xffff);
            }
          }
        }
      } else if (gi < NG) {
        unsigned char* cb = smem_raw + ((gi & 1) * 4 + (wave - 4)) * CB_SIZE;
        const int t = lane & 15, cg = lane >> 4, ch0 = cg * 16;
        const float* mup = p->in[I_MUP] + (size_t)l * 1920;
        const float* mun = p->in[I_MUN] + (size_t)l * 1920;
        const float* kkp = p->in[I_KK] + (size_t)l * 512 + h * 64 + ch0;
        const float* kap = p->in[I_KA] + (size_t)l * 512 + h * 64 + ch0;
        unsigned char* hs = smem_raw + 8 * CB_SIZE + (wave - 4) * 4608;
        const int step = (gi * 4 + (wave - 4)) * 16 + t;
        const int tp = d ? (SEQ - 1 - step) : step;
        uint4 HL0[11], K1[3], R1[8];
        {
          const u16* row_ = P + (tok0 + tp) * LDP;
          const int chn0_ = h * 64 + ch0, chn1_ = chn0_ + 8;
          HLD3(HL0, 3, 1, chn0_, tp, row_) HLD3(K1, 0, 1, chn1_, tp, row_)
          HLD3(HL0, 0, 0, chn0_, tp, row_) HLD3(HL0, 6, 2, chn0_, tp, row_)
          HL0[9] = *(const uint4*)(prepE + ((size_t)d * NT + tok0 + tp) * 512 + chn0_);
          HL0[10] = *(const uint4*)(prepA + ((size_t)d * NT + tok0 + tp) * 512 + chn0_);
          HLD3(R1, 0, 0, chn1_, tp, row_) HLD3(R1, 3, 2, chn1_, tp, row_)
          R1[6] = *(const uint4*)(prepE + ((size_t)d * NT + tok0 + tp) * 512 + chn1_);
          R1[7] = *(const uint4*)(prepA + ((size_t)d * NT + tok0 + tp) * 512 + chn1_);
        }
        float nrm = 0.f;
#pragma unroll
        for (int hh = 0; hh < 2; ++hh) {
          const int chn = h * 64 + ch0 + hh * 8;
          float tmp[8], tpv[8], tnv[8];
          if (hh == 0) { unpack8(HL0[3], tmp); unpack8(HL0[4], tpv); unpack8(HL0[5], tnv); }
          else { unpack8(K1[0], tmp); unpack8(K1[1], tpv); unpack8(K1[2], tnv); }
#pragma unroll
          for (int e = 0; e < 8; ++e) {
            float zz = tmp[e] + mup[512 + chn + e] * (tpv[e] - tmp[e]) + mun[512 + chn + e] * (tnv[e] - tmp[e]);
            zz *= kkp[hh * 8 + e];
            nrm += zz * zz;
          }
        }
        nrm = xor_sum(nrm, 16); nrm = xor_sum(nrm, 32);
        const float inv = __builtin_amdgcn_rcpf(fmaxf(sqrtf(nrm), 1e-12f));
#pragma unroll
        for (int hh = 0; hh < 2; ++hh) {
          const int chn = h * 64 + ch0 + hh * 8;
          float rs[8], ks[8], vs[8];
#pragma unroll
          for (int which = 0; which < 3; ++which) {
            float tmp[8], tpv[8], tnv[8];
            if (hh == 0) { unpack8(HL0[which * 3 + 0], tmp); unpack8(HL0[which * 3 + 1], tpv); unpack8(HL0[which * 3 + 2], tnv); }
            else if (which == 1) { unpack8(K1[0], tmp); unpack8(K1[1], tpv); unpack8(K1[2], tnv); }
            else { const int o_ = (which == 0) ? 0 : 3; unpack8(R1[o_ + 0], tmp); unpack8(R1[o_ + 1], tpv); unpack8(R1[o_ + 2], tnv); }
#pragma unroll
            for (int e = 0; e < 8; ++e) {
              float zz = tmp[e] + mup[which * 512 + chn + e] * (tpv[e] - tmp[e]) + mun[which * 512 + chn + e] * (tnv[e] - tmp[e]);
              if (which == 0) rs[e] = zz; else if (which == 1) ks[e] = zz; else vs[e] = zz;
            }
          }
          float ee[8], aa[8];
          if (hh == 0) { unpack8(HL0[9], ee); unpack8(HL0[10], aa); }
          else { unpack8(R1[6], ee); unpack8(R1[7], aa); }
          float o_kk[8], o_r[8], o_bh[8], o_kh[8];
          u16* wt = (u16*)(cb + CB_WT);
          const int sl = (t >> 2) * 8 + (t & 3);
#pragma unroll
          for (int c = 0; c < 8; ++c) {
            float x = ee[c];
            x += dpp_f<0x111>(x); x += dpp_f<0x112>(x); x += dpp_f<0x114>(x); x += dpp_f<0x118>(x);
            const float etot = dpp_f<0x15F>(x);
            const float knc = ks[c] * kkp[hh * 8 + c] * inv;
            const float bb = knc * aa[c];
            const float kd = ks[c] * (1.0f + (aa[c] - 1.0f) * kap[hh * 8 + c]);
            const float up = __expf(x);
            const float dn = __expf(x - etot);
            o_kk[c] = knc * __expf(ee[c] - x);
            o_r[c] = rs[c] * __expf(-x);
            o_bh[c] = bb * up;
            o_kh[c] = kd * up;
            const int j = ch0 + hh * 8 + c;
            wt[j * 40 + sl] = (u16)(pack2bf(bb * dn, 0.f) & 0xffff);
            wt[j * 40 + sl + 4] = (u16)(pack2bf(kd * dn, 0.f) & 0xffff);
            ((u16*)(cb + CB_VBT))[j * 24 + t] = (u16)(pack2bf(vs[c], 0.f) & 0xffff);
            if (t == 15) ((float*)(cb + CB_CC))[j] = __expf(-etot);
          }
#define ST8(ptr, arr) *(uint4*)((u16*)(ptr) + t * 72 + ch0 + hh * 8) = make_uint4(pack2bf(arr[0], arr[1]), pack2bf(arr[2], arr[3]), pack2bf(arr[4], arr[5]), pack2bf(arr[6], arr[7]));
          ST8(cb + CB_KKT, o_kk) ST8(cb + CB_RT, o_r) ST8(hs, o_bh) ST8(hs + 2304, o_kh)
          __builtin_amdgcn_sched_barrier(0);
        }
        f32x4 Nbk = {0.f, 0.f, 0.f, 0.f}, NbkT = Nbk, Nkk = Nbk, Mbr = Nbk, Mkr = Nbk;
#pragma unroll
        for (int ksx = 0; ksx < 2; ++ksx) {
          const int off = l15 * 72 + ksx * 32 + g * 8;
          const s16x8 fb = *(const s16x8*)((const u16*)(hs) + off), fk = *(const s16x8*)((const u16*)(hs + 2304) + off);
          const s16x8 fq = *(const s16x8*)((const u16*)(cb + CB_KKT) + off), fr = *(const s16x8*)((const u16*)(cb + CB_RT) + off);
          Nbk = mmbf(fb, fq, Nbk);
          NbkT = mmbf(fq, fb, NbkT);
          Nkk = mmbf(fk, fq, Nkk);
          Mbr = mmbf(fb, fr, Mbr);
          Mkr = mmbf(fk, fr, Mkr);
        }
#pragma unroll
        for (int r = 0; r < 4; ++r) {
          const int row_ = g * 4 + r;
          if (!(row_ < l15)) { Nbk[r] = 0.f; Nkk[r] = 0.f; }
          if (!(row_ <= l15)) { Mbr[r] = 0.f; Mkr[r] = 0.f; }
          if (!(l15 < row_)) NbkT[r] = 0.f;
        }
        *(uint2*)((u16*)(cb + CB_AN1) + l15 * 24 + g * 4) = cvt4bf(Nkk);
        {
          const uint2 a = cvt4bf(Mbr), bq = cvt4bf(Mkr);
          *(uint4*)((u16*)(cb + CB_AY) + l15 * 40 + g * 8) = make_uint4(a.x, a.y, bq.x, bq.y);
        }
        f32x4 idn;
#pragma unroll
        for (int r = 0; r < 4; ++r) idn[r] = (g * 4 + r == l15) ? 1.f : 0.f;
        const f32x4 N2 = mm16(NbkT, Nbk), N2T = mm16(Nbk, NbkT);
        const f32x4 N4 = mm16(N2T, N2), N4T = mm16(N2, N2T);
        const f32x4 N8 = mm16(N4T, N4);
        const f32x4 Z1 = mm16(idn + N4T, idn + N8);
        const f32x4 Z2 = mm16(idn + N2T, Z1);
        const f32x4 X = mm16(idn - NbkT, Z2);
        *(uint2*)((u16*)(cb + CB_AT) + l15 * 24 + g * 4) = cvt4bf(-X);
      }
      __syncthreads();
    }
  }
}

__device__ __forceinline__ void ph_post(int l) {
  const KP p = kparams();
  u16* P = (u16*)(p->ws + WS_P);
  const u16* gate = (const u16*)(p->ws + WS_GATE);
  const int tid_ = otid();
  const int wave = tid_ >> 6, lane = tid_ & 63;
  const int c0 = lane * 8;
  const float* mup = p->in[I_MUP] + (size_t)l * 1920;
  const float* mun = p->in[I_MUN] + (size_t)l * 1920;
  const float* gng = p->in[I_GNG] + (size_t)l * 512 + c0;
  const float* gnb = p->in[I_GNB] + (size_t)l * 512 + c0;
  const float* rkp = p->in[I_RK] + (size_t)l * 512 + c0;
#pragma unroll 2
  for (int t = blockIdx.x * 8 + wave; t < NT; t += gridDim.x * 8) {
    const int s = t & (SEQ - 1);
    const u16* row = P + (size_t)t * LDP;
    float y[8], f[8];
    { uint4 q = *(const uint4*)(row + PC_U + c0); unpack8(q, y); }
    { uint4 q = *(const uint4*)(row + PC_V + c0); unpack8(q, f); }
    float sum = 0.f;
#pragma unroll
    for (int e = 0; e < 8; ++e) { y[e] += f[e]; sum += y[e]; }
    sum = xor_sum(sum, 1); sum = xor_sum(sum, 2); sum = xor_sum(sum, 4);
    const float mu = sum * (1.0f / 64.0f);
    float var = 0.f;
#pragma unroll
    for (int e = 0; e < 8; ++e) { float dd = y[e] - mu; var += dd * dd; }
    var = xor_sum(var, 1); var = xor_sum(var, 2); var = xor_sum(var, 4);
    const float rs = rsqrtf(var * (1.0f / 64.0f) + 64e-5f);
    float rr[8], kk[8], vv[8], tmp[8], tp[8], tn[8];
#pragma unroll
    for (int which = 0; which < 3; ++which) {
      const int col = PC_R + which * 512 + c0;
      uint4 q = *(const uint4*)(row + col);
      unpack8(q, tmp);
      if (s > 0) { uint4 a = *(const uint4*)(row - LDP + col); unpack8(a, tp); }
      else {
#pragma unroll
        for (int e = 0; e < 8; ++e) tp[e] = 0.f;
      }
      if (s < SEQ - 1) { uint4 a = *(const uint4*)(row + LDP + col); unpack8(a, tn); }
      else {
#pragma unroll
        for (int e = 0; e < 8; ++e) tn[e] = 0.f;
      }
#pragma unroll
      for (int e = 0; e < 8; ++e) {
        float z = tmp[e] + mup[which * 512 + c0 + e] * (tp[e] - tmp[e]) + mun[which * 512 + c0 + e] * (tn[e] - tmp[e]);
        if (which == 0) rr[e] = z; else if (which == 1) kk[e] = z; else vv[e] = z;
      }
    }
    float bs = 0.f;
#pragma unroll
    for (int e = 0; e < 8; ++e) bs += rr[e] * kk[e] * rkp[e];
    bs = xor_sum(bs, 1); bs = xor_sum(bs, 2); bs = xor_sum(bs, 4);
    float gt[8], o[8];
    { uint4 q = *(const uint4*)(gate + (size_t)t * 512 + c0); unpack8(q, gt); }
#pragma unroll
    for (int e = 0; e < 8; ++e) o[e] = ((y[e] - mu) * rs * gng[e] + gnb[e] + bs * vv[e]) * gt[e];
    *(uint4*)(P + (size_t)t * LDP + PC_U + c0) = pack8(o);
  }
}

#define XB_TMO      128
#define XB_XCNT(j)  (256  + 64 * (j))
#define XB_XSUB(j)  (1280 + 64 * (j))
#define XB_XGEN(j)  (2304 + 64 * (j))
#define XB_TOP      3328
#define XB_TOPGEN   3392
#define XCD_BAR_WORDS 3456
#define XB_SPIN_CAP (1u << 18)
#define LAS __attribute__((address_space(3)))

__device__ __forceinline__ unsigned xb_ld(unsigned* p)              { return __hip_atomic_load(p, __ATOMIC_RELAXED, __HIP_MEMORY_SCOPE_AGENT); }
__device__ __forceinline__ unsigned xb_add(unsigned* p, unsigned v) { return __hip_atomic_fetch_add(p, v, __ATOMIC_RELAXED, __HIP_MEMORY_SCOPE_AGENT); }
__device__ __forceinline__ unsigned xb_xcc_id() { return (unsigned)__builtin_amdgcn_s_getreg((3 << 11) | 20) & 0xFu; }
#define XB_SPIN(cond, bar) do { unsigned _sp = 0; while (cond) { __builtin_amdgcn_s_sleep(1); \
    if ((++_sp & 255u) == 0u) { if (xb_ld(&(bar)[XB_TMO])) break; if (_sp > XB_SPIN_CAP) { atomicAdd(&(bar)[XB_TMO], 1u); break; } } } } while (0)

struct XcdBarrier {
    unsigned* bar; unsigned x;
    volatile LAS unsigned* st;
};

__device__ __forceinline__ XcdBarrier xcd_barrier_post(unsigned* bar, volatile LAS unsigned* st) {
    XcdBarrier b; b.bar = bar; b.x = xb_xcc_id(); b.st = st;
    if (threadIdx.x == 0) (void)xb_add(&bar[XB_XCNT(b.x)], 1u);
    return b;
}
__device__ __forceinline__ void xcd_barrier_complete(unsigned* bar, unsigned x, unsigned& nloc, unsigned& nx) {
    const unsigned G = gridDim.x * gridDim.y * gridDim.z;
    unsigned sum, cnt, mine, sp = 0u;
    for (;;) {
        sum = 0u; cnt = 0u; mine = 0u;
#pragma unroll
        for (unsigned j = 0; j < 16; ++j) { const unsigned c = xb_ld(&bar[XB_XCNT(j)]); sum += c; cnt += (c > 0u) ? 1u : 0u; mine = (j == x) ? c : mine; }
        if (sum == G) break;
        __builtin_amdgcn_s_sleep(1);
        if ((++sp & 255u) == 0u) { if (xb_ld(&bar[XB_TMO])) break; if (sp > XB_SPIN_CAP) { atomicAdd(&bar[XB_TMO], 1u); break; } }
    }
    nloc = mine > 0u ? mine : 1u; nx = cnt > 0u ? cnt : 1u;
}

__device__ __forceinline__ void xcd_barrier(const XcdBarrier& b) {
    asm volatile("s_waitcnt vmcnt(0)" ::: "memory");
    __syncthreads();
    if (threadIdx.x == 0) {
        unsigned* bar = b.bar;
        __builtin_amdgcn_s_waitcnt(0);
        unsigned nloc = b.st[0], nx = b.st[1];
        if (nloc == 0u) { xcd_barrier_complete(bar, b.x, nloc, nx); b.st[0] = nloc; b.st[1] = nx; }
        const unsigned old = xb_add(&bar[XB_XSUB(b.x)], 1u);
        const unsigned gen = old / nloc;
        if (old + 1u == (gen + 1u) * nloc) {
            __builtin_amdgcn_fence(__ATOMIC_RELEASE, "agent");
            asm volatile("s_waitcnt vmcnt(0)" ::: "memory");
            const unsigned og = xb_add(&bar[XB_TOP], 1u);
            const unsigned tg = og / nx;
            if (og + 1u == (tg + 1u) * nx) xb_add(&bar[XB_TOPGEN], 1u);
            else XB_SPIN(xb_ld(&bar[XB_TOPGEN]) == tg, bar);
            __builtin_amdgcn_fence(__ATOMIC_ACQUIRE, "agent");
            xb_add(&bar[XB_XGEN(b.x)], 1u);
            asm volatile("s_waitcnt vmcnt(0)" ::: "memory");
        } else {
            XB_SPIN(xb_ld(&bar[XB_XGEN(b.x)]) == gen, bar);
            __builtin_amdgcn_fence(__ATOMIC_ACQUIRE, "agent");
            asm volatile("s_waitcnt vmcnt(0)" ::: "memory");
        }
    }
    __syncthreads();
}

__device__ __forceinline__ void run_phase(int ph, unsigned char* smem) {
  const KP p = kparams();
  u16* wb = (u16*)(p->ws + WS_WB);
  u16* xn = (u16*)(p->ws + WS_XN);
  u16* P = (u16*)(p->ws + WS_P);
  u16* merged = (u16*)(p->ws + WS_PREP);
  u16* hid = (u16*)(p->ws + WS_P);
  if (ph == 0) {
    ph_convert(0, smem);
    ph_ln<1, 0>(p->in[I_X], p->in[I_LN0G], p->in[I_LN0B], p->out, xn);
    return;
  }
  const int l = (ph - 1) / 12, k = (ph - 1) % 12;
#ifndef REPEAT_MASK
#define REPEAT_MASK 0
#endif
  const int nrep = ((REPEAT_MASK >> k) & 1) ? 2 : 1;
  for (int rep = 0; rep < nrep; ++rep)
  switch (k) {
    case 0: ph_gemm256<EPI_BF16>(xn, 1024, wb + WO_IN, 1024, 1024, 3968, P, LDP, (u16*)smem); break;
    case 1:
#ifdef PROBE_ATTN
      ph_attn(l, smem, true);
#endif
      ph_attn(l, smem, false); break;
    case 2: ph_poolmix_lr(l); break;
    case 3: ph_prep_gemm(l, (u16*)smem); break;
    case 4: ph_scan(l, smem); break;
    case 5: ph_post(l); break;
    case 6: ph_merge(l, (u16*)smem); break;
    case 7: ph_gemm256<EPI_RES>(merged, 1024, wb + WO_OUT, 1024, 1024, 1024, xn, 1024, (u16*)smem); break;
    case 8: ph_ln<0, 0>(p->out, p->in[I_LN1G] + (size_t)l * 1024, p->in[I_LN1B] + (size_t)l * 1024, p->out, xn); break;
    case 9: ph_gemm256<EPI_RELU2>(xn, 1024, wb + WO_UP, 1024, 1024, 4096, hid, 4096, (u16*)smem); break;
    case 10: ph_gemm256<EPI_RES>(hid, 4096, wb + WO_DOWN, 4096, 4096, 1024, xn, 1024, (u16*)smem); break;
    case 11:
      if (l + 1 < DEPTH) ph_ln<0, 0>(p->out, p->in[I_LN2G] + (size_t)l * 1024, p->in[I_LN2B] + (size_t)l * 1024, p->out, xn);
      else ph_ln<0, 1>(p->out, p->in[I_LN2G] + (size_t)l * 1024, p->in[I_LN2B] + (size_t)l * 1024, p->out, xn);
      if (l + 1 < DEPTH) ph_convert(l + 1, smem);
      break;
  }
}

constexpr int N_PHASES = 1 + 12 * DEPTH;

__global__ void __launch_bounds__(NTHREADS) mega(Params p_unused) {
  extern __shared__ __attribute__((aligned(16))) unsigned char smem[];
  const KP kp = kparams();
  if (kp->ph_hi - kp->ph_lo == 1) {
    run_phase(kp->ph_lo, smem);
  } else {
    cg::grid_group grid = cg::this_grid();
    grid.sync();
    unsigned* bar = (unsigned*)(kp->ws + WS_BAR);
    volatile LAS unsigned* xst = (volatile LAS unsigned*)(smem + LDS_BYTES);
    if (otid() == 0) { xst[0] = 0u; xst[1] = 0u; xst[2] = 0u; xst[3] = 0u; }
    __syncthreads();
    XcdBarrier xb = xcd_barrier_post(bar, xst);
    const int ph_hi = kp->ph_hi;
    for (int ph = kp->ph_lo; ph < ph_hi; ++ph) {
      run_phase(ph, smem);
      if (ph + 1 < ph_hi) xcd_barrier(xb);
    }
  }
}

extern "C" void kernel_launch(void* const* d_in, const int* in_sizes, int n_in, void* d_out, int out_size, void* d_ws, size_t ws_size, hipStream_t stream) {
  static int grid_blocks = 0;
  if (!grid_blocks) {
    if (n_in != N_IN || ws_size < WS_END) { fprintf(stderr, "kernel_launch: unexpected n_in %d / ws %zu\n", n_in, ws_size); grid_blocks = -1; return; }
    int dev = 0, cus = 0, per_cu = 0;
    (void)hipGetDevice(&dev);
    (void)hipDeviceGetAttribute(&cus, hipDeviceAttributeMultiprocessorCount, dev);
    if (hipFuncSetAttribute((const void*)mega, hipFuncAttributeMaxDynamicSharedMemorySize, LDS_BYTES + 16) != hipSuccess) fprintf(stderr, "hipFuncSetAttribute failed\n");
    (void)hipOccupancyMaxActiveBlocksPerMultiprocessor(&per_cu, (const void*)mega, NTHREADS, LDS_BYTES + 16);
    if (per_cu < 1) { fprintf(stderr, "occupancy query says %d\n", per_cu); per_cu = 1; }
    grid_blocks = cus;
  }
  if (grid_blocks < 0) return;
  Params p{};
  for (int i = 0; i < N_IN; ++i) p.in[i] = (const float*)d_in[i];
  p.out = (float*)d_out;
  p.ws = (unsigned char*)d_ws;
#if MULTI_LAUNCH
  for (int ph = 0; ph < N_PHASES; ++ph) {
    p.ph_lo = ph; p.ph_hi = ph + 1;
    hipLaunchKernelGGL(mega, dim3(grid_blocks), dim3(NTHREADS), LDS_BYTES + 16, stream, p);
  }
#else
  (void)hipMemsetAsync((unsigned char*)d_ws + WS_BAR, 0, XCD_BAR_WORDS * 4, stream);
  p.ph_lo = 0; p.ph_hi = N_PHASES;
  void* args[] = {&p};
  hipError_t e = hipLaunchCooperativeKernel((void*)mega, dim3(grid_blocks), dim3(NTHREADS), args, LDS_BYTES + 16, stream);
  if (e != hipSuccess) fprintf(stderr, "cooperative launch failed: %s (grid %d)\n", hipGetErrorString(e), grid_blocks);
#endif
}
```
